# Optimizing an MI355X kernel written in HIP

```python
import math
import jax
import jax.numpy as jnp
from jax import lax
import numpy as np

D_MODEL = 1024
BATCH = 8
SEQ = 4096
DEPTH = 1

PLE_DIM = 256
GMLP_WIDTH = 1024
GMLP_GROUPS = 8
GMLP_CHUNK = 128
MOBA_HEADS = 8
MOBA_HEAD_DIM = 128
MOBA_WIDTH = MOBA_HEADS * MOBA_HEAD_DIM
MOBA_BLOCK = 256
MOBA_TOPK = 3
MOBA_QCHUNK = 32
REL_BUCKETS = 32
REL_MAX_DISTANCE = 1024
PEER_HEADS = 8
PEER_N_KEYS = 128
PEER_N_EXPERTS = PEER_N_KEYS * PEER_N_KEYS
PEER_TOPK = 16
PEER_KEY_DIM = 256
PEER_KEY_HALF = PEER_KEY_DIM // 2
PEER_TOK_CHUNK = 128
IN_WIDTHS = (GMLP_WIDTH, GMLP_WIDTH, MOBA_WIDTH, MOBA_WIDTH, MOBA_WIDTH, D_MODEL, D_MODEL)
IN_TOTAL = sum(IN_WIDTHS)
LN_EPS = 1e-5
NEG_INF = -1e30

kernel_name = 'hybrid_gmlp_moba_peer_block'


def layer_norm(x, g, b):
    xf = x.astype(jnp.float32)
    mu = jnp.mean(xf, axis=-1, keepdims=True)
    var = jnp.mean(jnp.square(xf - mu), axis=-1, keepdims=True)
    y = (xf - mu) * lax.rsqrt(var + LN_EPS) * g.astype(jnp.float32) + b.astype(jnp.float32)
    return y.astype(x.dtype)


def t5_bucket(dist):
    n = jnp.maximum(dist, 0)
    max_exact = REL_BUCKETS // 2
    nf = jnp.maximum(n, max_exact).astype(jnp.float32)
    large = max_exact + (jnp.log(nf / max_exact) / math.log(REL_MAX_DISTANCE / max_exact)
                         * (REL_BUCKETS - max_exact)).astype(jnp.int32)
    large = jnp.minimum(large, REL_BUCKETS - 1)
    return jnp.where(n < max_exact, n, large)


def gmlp_spatial_gating(u, v, ln_g, ln_b, w_s, b_s):
    bsz, seq, width = v.shape
    v = layer_norm(v, ln_g, ln_b)
    vc = v.reshape(bsz, seq // GMLP_CHUNK, GMLP_CHUNK, GMLP_GROUPS, width // GMLP_GROUPS)
    w_causal = jnp.tril(w_s)
    s = jnp.einsum('gts,bnsgc->bntgc', w_causal, vc) + b_s.T[None, None, :, :, None]
    return u * s.reshape(bsz, seq, width)


def moba_attention(q, k, v, rel_bias):
    bsz, seq, nh, hd = q.shape
    nb = -(-seq // MOBA_BLOCK)
    s_pad = nb * MOBA_BLOCK
    pad = ((0, 0), (0, s_pad - seq), (0, 0), (0, 0))
    q, k, v = (jnp.pad(t, pad).transpose(0, 2, 1, 3) for t in (q, k, v))
    kb = k.reshape(bsz, nh, nb, MOBA_BLOCK, hd)
    vb = v.reshape(bsz, nh, nb, MOBA_BLOCK, hd)
    scale = hd ** -0.5

    k_mean = jnp.mean(kb.astype(jnp.float32), axis=3).astype(q.dtype)
    gate = jnp.einsum('bhtd,bhnd->bhtn', q, k_mean).astype(jnp.float32)
    q_blk = jnp.arange(s_pad) // MOBA_BLOCK
    past = jnp.arange(nb)[None, :] < q_blk[:, None]
    gate = jnp.where(past, gate, NEG_INF)
    n_sel = min(MOBA_TOPK, nb)
    _, sel = lax.top_k(gate, n_sel)
    sel_valid = jnp.arange(n_sel)[None, :] < q_blk[:, None]

    n_chunks = s_pad // MOBA_QCHUNK
    q_c = q.reshape(bsz, nh, n_chunks, MOBA_QCHUNK, hd).transpose(2, 0, 1, 3, 4)
    sel_c = sel.reshape(bsz, nh, n_chunks, MOBA_QCHUNK, n_sel).transpose(2, 0, 1, 3, 4)
    valid_c = sel_valid.reshape(n_chunks, MOBA_QCHUNK, n_sel)
    b_idx = jnp.arange(bsz)[:, None, None]
    h_idx = jnp.arange(nh)[None, :, None]
    bias_h = rel_bias.T.astype(jnp.float32)
    offs = jnp.arange(MOBA_BLOCK)

    def chunk_attend(args):
        c, qc, selc, validc = args
        t = c * MOBA_QCHUNK + jnp.arange(MOBA_QCHUNK)
        own = (c * MOBA_QCHUNK) // MOBA_BLOCK
        k_own = lax.dynamic_index_in_dim(kb, own, axis=2, keepdims=False)
        v_own = lax.dynamic_index_in_dim(vb, own, axis=2, keepdims=False)
        d_own = t[:, None] - (own * MOBA_BLOCK + offs)[None, :]
        l_own = (jnp.einsum('bhqd,bhkd->bhqk', qc, k_own).astype(jnp.float32) * scale
                 + bias_h[:, t5_bucket(d_own)])
        logits = [jnp.where(d_own >= 0, l_own, NEG_INF)]
        for r in range(n_sel):
            idx = selc[..., r]
            k_g = kb[b_idx, h_idx, idx]
            d_r = t[:, None] - (idx[..., None] * MOBA_BLOCK + offs)
            l_r = (jnp.einsum('bhqd,bhqkd->bhqk', qc, k_g).astype(jnp.float32) * scale
                   + bias_h[h_idx[..., None], t5_bucket(d_r)])
            logits.append(jnp.where(validc[None, None, :, r, None], l_r, NEG_INF))
        w = jax.nn.softmax(jnp.concatenate(logits, axis=-1), axis=-1).astype(qc.dtype)
        out = jnp.einsum('bhqk,bhkd->bhqd', w[..., :MOBA_BLOCK], v_own)
        for r in range(n_sel):
            v_g = vb[b_idx, h_idx, selc[..., r]]
            w_r = w[..., (r + 1) * MOBA_BLOCK:(r + 2) * MOBA_BLOCK]
            out = out + jnp.einsum('bhqk,bhqkd->bhqd', w_r, v_g)
        return out

    out = lax.map(chunk_attend, (jnp.arange(n_chunks), q_c, sel_c, valid_c))
    out = out.transpose(1, 0, 3, 2, 4).reshape(bsz, s_pad, nh * hd)
    return out[:, :seq]


def peer_ffn(h, w_q, sub_keys, u_tab, v_tab):
    bsz, seq, d = h.shape
    n_tok = bsz * seq
    xt = h.reshape(n_tok, d)
    q = (xt @ w_q).reshape(n_tok, PEER_HEADS, 2, PEER_KEY_HALF)
    s = jnp.einsum('thpk,pnk->thpn', q, sub_keys).astype(jnp.float32)
    top_s, top_i = lax.top_k(s, PEER_TOPK)
    n_cand = PEER_TOPK * PEER_TOPK
    cand_s = (top_s[:, :, 0, :, None] + top_s[:, :, 1, None, :]).reshape(n_tok, PEER_HEADS, n_cand)
    cand_i = (top_i[:, :, 0, :, None] * PEER_N_KEYS + top_i[:, :, 1, None, :]).reshape(n_tok, PEER_HEADS, n_cand)
    best_s, best_pos = lax.top_k(cand_s, PEER_TOPK)
    experts = jnp.take_along_axis(cand_i, best_pos, axis=-1)
    gates = jax.nn.softmax(best_s, axis=-1).astype(h.dtype)
    n_chunks = n_tok // PEER_TOK_CHUNK

    def chunk_ffn(args):
        xc, ec, gc = args
        hid = jax.nn.gelu(jnp.einsum('chkd,cd->chk', u_tab[ec], xc), approximate=False)
        return jnp.einsum('chk,chkd->cd', gc * hid, v_tab[ec])

    y = lax.map(chunk_ffn, (xt.reshape(n_chunks, PEER_TOK_CHUNK, d),
                            experts.reshape(n_chunks, PEER_TOK_CHUNK, PEER_HEADS, PEER_TOPK),
                            gates.reshape(n_chunks, PEER_TOK_CHUNK, PEER_HEADS, PEER_TOPK)))
    return y.reshape(bsz, seq, d)


def setup_inputs(seed: int = 0) -> dict:
    key = jax.random.key(seed)
    ks = jax.random.split(key, 24)
    f32 = jnp.float32
    beta = (8.0 * DEPTH) ** -0.25

    def nrm(k, shape, s):
        return jax.random.normal(k, shape, f32) * s

    v_off = 2 * GMLP_WIDTH + 2 * MOBA_WIDTH
    col_scale = jnp.ones((IN_TOTAL,), f32).at[v_off:v_off + MOBA_WIDTH].set(beta)
    return {
        'x': nrm(ks[0], (BATCH, SEQ, D_MODEL), 1.0),
        'p': nrm(ks[1], (DEPTH, BATCH, SEQ, PLE_DIM), 1.0),
        'w_in': nrm(ks[2], (DEPTH, D_MODEL, IN_TOTAL), D_MODEL ** -0.5) * col_scale,
        'b_in': nrm(ks[3], (DEPTH, IN_TOTAL), 0.02),
        'gmlp_ln_g': 1.0 + nrm(ks[4], (DEPTH, GMLP_WIDTH), 0.02),
        'gmlp_ln_b': nrm(ks[5], (DEPTH, GMLP_WIDTH), 0.02),
        'gmlp_w_s': nrm(ks[6], (DEPTH, GMLP_GROUPS, GMLP_CHUNK, GMLP_CHUNK), GMLP_CHUNK ** -0.5),
        'gmlp_b_s': 1.0 + nrm(ks[7], (DEPTH, GMLP_GROUPS, GMLP_CHUNK), 0.02),
        'w_proj_a': nrm(ks[8], (DEPTH, GMLP_WIDTH, D_MODEL), beta * GMLP_WIDTH ** -0.5),
        'w_proj_b': nrm(ks[9], (DEPTH, MOBA_WIDTH, D_MODEL), beta * MOBA_WIDTH ** -0.5),
        'w_out': nrm(ks[10], (DEPTH, D_MODEL, D_MODEL), beta * D_MODEL ** -0.5),
        'ln1_g': 1.0 + nrm(ks[11], (DEPTH, D_MODEL), 0.02),
        'ln1_b': nrm(ks[12], (DEPTH, D_MODEL), 0.02),
        'rel_bias': nrm(ks[13], (REL_BUCKETS, MOBA_HEADS), 0.5),
        'peer_w_q': nrm(ks[14], (DEPTH, D_MODEL, PEER_HEADS * PEER_KEY_DIM), D_MODEL ** -0.5),
        'peer_sub_keys': nrm(ks[15], (DEPTH, 2, PEER_N_KEYS, PEER_KEY_HALF), PEER_KEY_HALF ** -0.5),
        'peer_u': nrm(ks[16], (DEPTH, PEER_N_EXPERTS, D_MODEL), D_MODEL ** -0.5),
        'peer_v': nrm(ks[17], (DEPTH, PEER_N_EXPERTS, D_MODEL), beta * PEER_HEADS ** -0.5),
        'ple_w_proj': nrm(ks[18], (DEPTH, PLE_DIM, D_MODEL), beta * PLE_DIM ** -0.5),
        'ple_w_gate': nrm(ks[19], (DEPTH, D_MODEL, D_MODEL), D_MODEL ** -0.5),
        'ple_b_gate': nrm(ks[20], (DEPTH, D_MODEL), 0.02),
        'ln2_g': 1.0 + nrm(ks[21], (DEPTH, D_MODEL), 0.02),
        'ln2_b': nrm(ks[22], (DEPTH, D_MODEL), 0.02),
    }


def reference(x, p, w_in, b_in, gmlp_ln_g, gmlp_ln_b, gmlp_w_s, gmlp_b_s, w_proj_a, w_proj_b,
              w_out, ln1_g, ln1_b, rel_bias, peer_w_q, peer_sub_keys, peer_u, peer_v,
              ple_w_proj, ple_w_gate, ple_b_gate, ln2_g, ln2_b):
    alpha = (2.0 * DEPTH) ** 0.25
    bsz, seq, _ = x.shape
    splits = [sum(IN_WIDTHS[:j + 1]) for j in range(len(IN_WIDTHS) - 1)]
    for i in range(DEPTH):
        z = x @ w_in[i] + b_in[i]
        u_a, v_a, q_b, k_b, v_b, g_a, g_b = jnp.split(z, splits, axis=-1)
        a = gmlp_spatial_gating(jax.nn.gelu(u_a, approximate=False), jax.nn.gelu(v_a, approximate=False),
                                gmlp_ln_g[i], gmlp_ln_b[i], gmlp_w_s[i], gmlp_b_s[i])
        head_shape = (bsz, seq, MOBA_HEADS, MOBA_HEAD_DIM)
        o = moba_attention(q_b.reshape(head_shape), k_b.reshape(head_shape), v_b.reshape(head_shape), rel_bias)
        m = jax.nn.sigmoid(g_a) * (a @ w_proj_a[i]) + jax.nn.sigmoid(g_b) * (o @ w_proj_b[i])
        h = layer_norm(alpha * x + m @ w_out[i], ln1_g[i], ln1_b[i])
        f = peer_ffn(h, peer_w_q[i], peer_sub_keys[i], peer_u[i], peer_v[i])
        e = (p[i] @ ple_w_proj[i]) * jax.nn.sigmoid(h @ ple_w_gate[i] + ple_b_gate[i])
        x = layer_norm(alpha * h + f + e, ln2_g[i], ln2_b[i])
    return x
```

```cpp
#include <hip/hip_runtime.h>
#include <hip/hip_cooperative_groups.h>
#include <cstdio>
#include <cstdint>
#ifndef PG8_AL
#define PG8_AL true
#endif
#ifndef PG8_AL1
#define PG8_AL1 PG8_AL
#endif
#ifndef PG8_S2
#define PG8_S2 true
#endif
namespace pg8 {
#define PG8_LAS __attribute__((address_space(3)))
typedef unsigned short bf16_t;
typedef short bf16x8 __attribute__((ext_vector_type(8)));
typedef float f32x4 __attribute__((ext_vector_type(4)));
typedef unsigned u32x4 __attribute__((ext_vector_type(4)));
constexpr int BM = 256, BK = 64, HALF = 128, HTB = HALF * BK * 2  , STAGE_BYTES = 8 * HTB, NXCD = 8, WGM = 8;

__host__ __device__ __forceinline__ int lds_byte(int r, int c) { const int st = (r >> 4) * 2 + (c >> 5), rr = r & 15, cc = c & 31, ob = rr * 64 + cc * 2; return st * 1024 + (ob ^ (((ob >> 9) & 1) << 5)); }
__host__ __device__ __forceinline__ void stage_rc(int b, int& R, int& C) { const int st = b / 1024, sb = b % 1024, swz = sb ^ (((sb >> 9) & 1) << 5); R = (st >> 1) * 16 + swz / 64; C = (st & 1) * 32 + (swz % 64) / 2; }
__host__ __device__ __forceinline__ int perm32(int rho) { const int n = rho >> 4, i = rho & 15; return 8 * (i >> 2) + 4 * n + (i & 3); }

struct Unit { int pm, pn, half; };
struct Gemm { const bf16_t* A; const bf16_t* Bt; int M, N, K; const bf16_t* A2; const bf16_t* Bt2; };

struct StaticOrder {
    int nM, nN, nwg, G, c;
    __host__ __device__ void init(int M, int N, int G_, int c_) { nM = M / BM; nN = N / BM; nwg = nM * nN; G = G_; c = c_; }
    __host__ __device__ bool next(int i, Unit& u) const {
        const long L = (long)i * G + c; if (L >= nwg) return false;
        int wgid = (int)L; { const int q = nwg / NXCD, r = nwg % NXCD, xcd = wgid % NXCD, off = wgid / NXCD; wgid = (xcd < r ? xcd * (q + 1) : r * (q + 1) + (xcd - r) * q) + off; }
        const int nig = WGM * nN, gid = wgid / nig, fm = gid * WGM, gsz = (nM - fm) < WGM ? (nM - fm) : WGM;
        u.pm = fm + ((wgid % nig) % gsz); u.pn = (wgid % nig) / gsz; u.half = 0; return true;
    }
    __device__ __forceinline__ void a_ready(const Unit&) const {}
    __device__ __forceinline__ void done(const Unit&) const {}
};
struct DualOrder : StaticOrder {
    __host__ __device__ bool next(int i, Unit& u) const { if (!StaticOrder::next(i >> 1, u)) return false; u.half = i & 1; return true; }
};
__device__ __forceinline__ unsigned cvt_pk_bf16(float lo, float hi) { unsigned r; asm volatile("v_cvt_pk_bf16_f32 %0, %1, %2" : "=v"(r) : "v"(lo), "v"(hi)); return r; }
typedef float f32x2 __attribute__((ext_vector_type(2)));
__device__ __forceinline__ f32x2 gelu_pk(f32x2 v) {
    const f32x2 av = __builtin_elementwise_abs(v), d = av * 0.2316418882f + 1.0f;
    f32x2 t; t.x = __builtin_amdgcn_rcpf(d.x); t.y = __builtin_amdgcn_rcpf(d.y);
    f32x2 q = t * 0.5307027145f + (-0.7265760135f); q = q * t + 0.7107068705f; q = q * t + (-0.142248368f); q = q * t + 0.127414796f; q = q * t;
    const f32x2 s = (v * v) * (-0.72134752044f);
    f32x2 e; e.x = __builtin_amdgcn_exp2f(s.x); e.y = __builtin_amdgcn_exp2f(s.y);
    const f32x2 m = v * (q * e), r = v - m;
    f32x2 o; o.x = v.x < 0.f ? m.x : r.x; o.y = v.y < 0.f ? m.y : r.y; return o;
}
typedef int i32x8_t __attribute__((ext_vector_type(8)));
__device__ __forceinline__ i32x8_t cat8(bf16x8 lo, bf16x8 hi) { typedef int i32x4_t __attribute__((ext_vector_type(4))); const i32x4_t a = __builtin_bit_cast(i32x4_t, lo), b = __builtin_bit_cast(i32x4_t, hi); return __builtin_shufflevector(a, b, 0, 1, 2, 3, 4, 5, 6, 7); }
template <class Epi, class Sched, bool ALIGN_EPI = false, bool SP2 = false, bool F8 = false>
__device__ __forceinline__ void gemm_phase(PG8_LAS unsigned char* lds, const Gemm g, const Sched& S, const Epi& E) {
    const int tid = threadIdx.x, wid = __builtin_amdgcn_readfirstlane(tid >> 6), lane = tid & 63, wr = wid >> 2, wc = wid & 3, fr = lane & 15, fq = lane >> 4;
    const int K = g.K, Kb = F8 ? K : 2 * K  , nt = Kb / (2 * BK);
    unsigned voffA[2], voffB[2];
#pragma unroll
    for (int i = 0; i < 2; ++i) { int R, C; stage_rc(tid * 16 + i * 8192, R, C); const int Rb = Epi::PERM ? (64 * (R >> 5) + perm32(R & 31)) : R;
        voffA[i] = (unsigned)(R * Kb + C * 2); voffB[i] = (unsigned)(Rb * Kb + C * 2); }
    const size_t kstep = (size_t)(BK * 2);
    const size_t hstep = (size_t)HALF * Kb;
    const size_t hstepB = Epi::PERM ? (size_t)32 * Kb : hstep;
    const size_t tstep = 2 * hstep;
    const unsigned ldsw = (unsigned)wid * 1024u;
    const int aoff = lds_byte(wr * 64 + fr, fq * 8), boff = lds_byte(wc * 32 + fr, fq * 8);
#define PG8_SA(b, h) (((b) * 2 + (h)) * HTB)
#define PG8_SB(b, h) ((4 + (b) * 2 + (h)) * HTB)
#ifndef PG8_AUX_A
#define PG8_AUX_A 0
#endif
#ifndef PG8_AUX_B
#define PG8_AUX_B 0
#endif
#define PG8_STAGE(bufoff, gbase, voff) do { _Pragma("unroll") for (int _i = 0; _i < 2; ++_i) { \
        if ((bufoff) < 4 * HTB) __builtin_amdgcn_global_load_lds((const unsigned*)((const char*)(gbase) + (voff)[_i]), (PG8_LAS unsigned*)(lds + (bufoff) + ldsw + _i * 8192), 16, 0, PG8_AUX_A); \
        else __builtin_amdgcn_global_load_lds((const unsigned*)((const char*)(gbase) + (voff)[_i]), (PG8_LAS unsigned*)(lds + (bufoff) + ldsw + _i * 8192), 16, 0, PG8_AUX_B); } } while (0)
#define PG8_LDA(dst, b, h) do { _Pragma("unroll") for (int m = 0; m < 4; ++m) _Pragma("unroll") for (int k = 0; k < 2; ++k) dst[m][k] = *(const PG8_LAS bf16x8*)(lds + PG8_SA(b, h) + aoff + m * 2048 + k * 1024); } while (0)
#define PG8_LDB(dst, b, h) do { _Pragma("unroll") for (int n = 0; n < 2; ++n) _Pragma("unroll") for (int k = 0; k < 2; ++k) dst[n][k] = *(const PG8_LAS bf16x8*)(lds + PG8_SB(b, h) + boff + n * 2048 + k * 1024); } while (0)
#define PG8_MMA_BF(ai, bj, At, Bt) do { _Pragma("unroll") for (int m = 0; m < 4; ++m) _Pragma("unroll") for (int n = 0; n < 2; ++n) _Pragma("unroll") for (int k = 0; k < 2; ++k) \
        acc[ai][bj][m][n] = __builtin_amdgcn_mfma_f32_16x16x32_bf16(Bt[n][k], At[m][k], acc[ai][bj][m][n], 0, 0, 0); } while (0)
#define PG8_MMA_F8(ai, bj, At, Bt) do { _Pragma("unroll") for (int m = 0; m < 4; ++m) _Pragma("unroll") for (int n = 0; n < 2; ++n) \
        asm volatile("v_mfma_scale_f32_16x16x128_f8f6f4 %0, %1, %2, %0, %3, %3 op_sel_hi:[0,0,0]" : "+v"(acc[ai][bj][m][n]) : "v"(*(const i32x8_t*)&Bt[n][0]), "v"(*(const i32x8_t*)&At[m][0]), "v"(0x7f7f7f7f)); } while (0)
#define PG8_MMA(ai, bj, At, Bt) do { __builtin_amdgcn_s_setprio(1); if constexpr (F8) { PG8_MMA_F8(ai, bj, At, Bt); } else { PG8_MMA_BF(ai, bj, At, Bt); } __builtin_amdgcn_s_setprio(0); } while (0)
#define PG8_WAIT_V(n) asm volatile("s_waitcnt vmcnt(" #n ")" ::: "memory")
#define PG8_WAIT_L(n) asm volatile("s_waitcnt lgkmcnt(" #n ")" ::: "memory")
#define PG8_BAR __builtin_amdgcn_s_barrier()
#define PG8_SCHED __builtin_amdgcn_sched_barrier(0)
    Unit cur, nxt; int ui = 0;
    if (!S.next(0, cur)) return;
    f32x4 acc[2][2][4][2];
#pragma unroll
    for (int a = 0; a < 2; ++a)
#pragma unroll
        for (int b = 0; b < 2; ++b)
#pragma unroll
            for (int m = 0; m < 4; ++m)
#pragma unroll
                for (int n = 0; n < 2; ++n) acc[a][b][m][n] = (f32x4){0.f, 0.f, 0.f, 0.f};
    bf16x8 At[4][2], B0[2][2], B1[2][2];
    const char* cA = (const char*)(cur.half ? g.A2 : g.A) + (size_t)cur.pm * tstep; const char* cB = (const char*)(cur.half ? g.Bt2 : g.Bt) + (size_t)cur.pn * tstep;
    S.a_ready(cur);
    if constexpr (SP2) {
        PG8_STAGE(PG8_SB(0, 0), cB, voffB); PG8_STAGE(PG8_SB(0, 1), cB + hstepB, voffB); PG8_STAGE(PG8_SA(0, 0), cA, voffA); PG8_STAGE(PG8_SA(0, 1), cA + hstep, voffA);
        if (wr == 1) PG8_BAR;
        PG8_WAIT_V(2); PG8_BAR;
        PG8_STAGE(PG8_SB(1, 0), cB + kstep, voffB); PG8_STAGE(PG8_SA(1, 0), cA + kstep, voffA); PG8_STAGE(PG8_SB(1, 1), cB + hstepB + kstep, voffB);
        PG8_WAIT_V(6); PG8_BAR;
    } else {
        PG8_STAGE(PG8_SB(0, 0), cB, voffB); PG8_STAGE(PG8_SA(0, 0), cA, voffA); PG8_STAGE(PG8_SB(0, 1), cB + hstepB, voffB); PG8_STAGE(PG8_SA(0, 1), cA + hstep, voffA);
        if (wr == 1) PG8_BAR;
        PG8_WAIT_V(4); PG8_BAR;
        PG8_STAGE(PG8_SB(1, 0), cB + kstep, voffB); PG8_STAGE(PG8_SA(1, 0), cA + kstep, voffA); PG8_STAGE(PG8_SB(1, 1), cB + hstepB + kstep, voffB);
        PG8_WAIT_V(6); PG8_BAR;
    }
    for (;;) {
        const bool has_next = S.next(ui + 1, nxt);
        const char* nA = has_next ? (const char*)(nxt.half ? g.A2 : g.A) + (size_t)nxt.pm * tstep : cA; const char* nB = has_next ? (const char*)(nxt.half ? g.Bt2 : g.Bt) + (size_t)nxt.pn * tstep : cB;
        for (int t = 0; t < nt; t += 2) {
            const bool last = (t == nt - 2);
            const char* a1 = cA + (size_t)(t + 1) * kstep;
            const char* a2 = last ? nA : cA + (size_t)(t + 2) * kstep; const char* b2 = last ? nB : cB + (size_t)(t + 2) * kstep;
            const char* a3 = a2 + kstep; const char* b3 = b2 + kstep;
            if (last && has_next) S.a_ready(nxt);
            if constexpr (SP2) {
            PG8_LDB(B0, 0, 0); PG8_LDB(B1, 0, 1); PG8_SCHED; PG8_LDA(At, 0, 0); PG8_STAGE(PG8_SA(1, 1), a1 + hstep, voffA);
            PG8_WAIT_V(8); PG8_WAIT_L(0); PG8_BAR; PG8_MMA(0, 0, At, B0); PG8_MMA(0, 1, At, B1); PG8_BAR; PG8_SCHED;
            PG8_LDA(At, 0, 1); PG8_STAGE(PG8_SB(0, 0), b2, voffB); PG8_STAGE(PG8_SB(0, 1), b2 + hstepB, voffB); PG8_STAGE(PG8_SA(0, 0), a2, voffA);
            PG8_WAIT_V(8); PG8_WAIT_L(0); PG8_BAR; PG8_MMA(1, 0, At, B0); PG8_MMA(1, 1, At, B1); PG8_BAR; PG8_SCHED;
            PG8_LDB(B0, 1, 0); PG8_LDB(B1, 1, 1); PG8_SCHED; PG8_LDA(At, 1, 0); PG8_STAGE(PG8_SA(0, 1), a2 + hstep, voffA);
            PG8_WAIT_V(8); PG8_WAIT_L(0); PG8_BAR; PG8_MMA(0, 0, At, B0); PG8_MMA(0, 1, At, B1); PG8_BAR; PG8_SCHED;
            PG8_LDA(At, 1, 1); PG8_STAGE(PG8_SB(1, 0), b3, voffB); PG8_STAGE(PG8_SB(1, 1), b3 + hstepB, voffB); PG8_STAGE(PG8_SA(1, 0), a3, voffA);
            PG8_WAIT_V(8); PG8_WAIT_L(0); PG8_BAR; PG8_MMA(1, 0, At, B0); PG8_MMA(1, 1, At, B1); PG8_BAR; PG8_SCHED;
            } else {
            PG8_LDB(B0, 0, 0); PG8_SCHED; PG8_LDA(At, 0, 0); PG8_STAGE(PG8_SA(1, 1), a1 + hstep, voffA);
            PG8_WAIT_L(8); PG8_BAR; PG8_WAIT_L(0); PG8_MMA(0, 0, At, B0); PG8_BAR; PG8_SCHED;
            PG8_LDB(B1, 0, 1); PG8_STAGE(PG8_SB(0, 0), b2, voffB);
            PG8_BAR; PG8_WAIT_L(0); PG8_MMA(0, 1, At, B1); PG8_BAR;
            PG8_LDA(At, 0, 1); PG8_STAGE(PG8_SA(0, 0), a2, voffA);
            PG8_BAR; PG8_WAIT_L(0); PG8_MMA(1, 0, At, B0); PG8_BAR; PG8_SCHED;
            PG8_STAGE(PG8_SB(0, 1), b2 + hstepB, voffB);
            PG8_WAIT_V(6); PG8_BAR; PG8_MMA(1, 1, At, B1); PG8_BAR;
            PG8_LDB(B0, 1, 0); PG8_SCHED; PG8_LDA(At, 1, 0); PG8_STAGE(PG8_SA(0, 1), a2 + hstep, voffA);
            PG8_WAIT_L(8); PG8_BAR; PG8_WAIT_L(0); PG8_MMA(0, 0, At, B0); PG8_BAR; PG8_SCHED;
            PG8_LDB(B1, 1, 1); PG8_STAGE(PG8_SB(1, 0), b3, voffB);
            PG8_BAR; PG8_WAIT_L(0); PG8_MMA(0, 1, At, B1); PG8_BAR;
            PG8_LDA(At, 1, 1); PG8_STAGE(PG8_SA(1, 0), a3, voffA);
            PG8_BAR; PG8_WAIT_L(0); PG8_MMA(1, 0, At, B0); PG8_BAR; PG8_SCHED;
            PG8_STAGE(PG8_SB(1, 1), b3 + hstepB, voffB);
            PG8_WAIT_V(6); PG8_BAR; PG8_MMA(1, 1, At, B1); PG8_BAR;
            }
        }
        if constexpr (F8) asm volatile("s_nop 15\n\ts_nop 15\n\ts_nop 15\n\ts_nop 15\n\ts_nop 15" ::: "memory");
        if constexpr (ALIGN_EPI) { if (wr == 0) PG8_BAR; }
        if constexpr (!Epi::AFTER_DRAIN) { E(acc, cur, wr, wc, fr, fq); S.done(cur); }
        if (!has_next) break;
        if (!(Epi::HAS_MID && cur.half == 0 && nxt.half == 1))
#pragma unroll
        for (int a = 0; a < 2; ++a)
#pragma unroll
            for (int b = 0; b < 2; ++b)
#pragma unroll
                for (int m = 0; m < 4; ++m)
#pragma unroll
                    for (int n = 0; n < 2; ++n) acc[a][b][m][n] = (f32x4){0.f, 0.f, 0.f, 0.f};
        cur = nxt; cA = nA; cB = nB; ++ui;
        if constexpr (ALIGN_EPI) { if (wr == 1) PG8_BAR; }
    }
    PG8_WAIT_V(0);
    if constexpr (!ALIGN_EPI) { if (wr == 0) PG8_BAR; }
    PG8_BAR;
    if constexpr (Epi::AFTER_DRAIN) { E.fused(acc, cur, wr, wc, fr, fq, lds, wid, lane); S.done(cur); }
#undef PG8_SA
#undef PG8_SB
#undef PG8_STAGE
#undef PG8_LDA
#undef PG8_LDB
#undef PG8_MMA
#undef PG8_WAIT_V
#undef PG8_WAIT_L
#undef PG8_BAR
#undef PG8_SCHED
}
}

namespace cg = cooperative_groups;
#define LAS __attribute__((address_space(3)))
typedef unsigned short bf16_t;
typedef short bf16x8 __attribute__((ext_vector_type(8)));
typedef float f32x4 __attribute__((ext_vector_type(4)));
typedef float f32x2 __attribute__((ext_vector_type(2)));
typedef float f32x16 __attribute__((ext_vector_type(16)));
typedef unsigned u32x4 __attribute__((ext_vector_type(4)));
typedef unsigned u32x2 __attribute__((ext_vector_type(2)));
typedef int i32x4 __attribute__((ext_vector_type(4)));

constexpr int T_TOK = 32768, DM = 1024, NZ = 7168, SEQ = 4096, NBATCH = 8, NHEAD = 8, HD = 128;
constexpr int NWAVES = 8, NTHR = 512;
constexpr float LN_EPS = 1e-5f;
constexpr float ALPHA = 1.189207115002721f;
constexpr float ATT_SCALE = 0.08838834764831845f;
constexpr int LUTN = 1280, LUT_OFF = 256;
constexpr int NPAIR = 128;
constexpr size_t MiB = 1u << 20;
constexpr size_t WS_WIN_T = 1 * MiB, WS_PA_T = 15 * MiB, WS_PB_T = 17 * MiB, WS_WOUT_T = 19 * MiB, WS_WQ2_T = 21 * MiB, WS_WPLE_T = 27 * MiB;
constexpr size_t WS_LUT = 27 * MiB + 512 * 1024, WS_KSUM = 28 * MiB;
constexpr size_t WS_PU = 32 * MiB, WS_PV = 48 * MiB, WS_H8 = 64 * MiB, WS_W = 80 * MiB, WS_PB16 = 96 * MiB;
constexpr size_t WS_R0 = 112 * MiB, WS_R1 = 176 * MiB, WS_R2 = 240 * MiB, WS_R3 = 304 * MiB, WS_R4 = 368 * MiB, WS_R5 = 432 * MiB, WS_END = 496 * MiB;
constexpr int LDS_BYTES = 147456;
constexpr int LDS_BAR_OFF = LDS_BYTES - 16;
constexpr size_t WS_BAR = 65536, WS_BAR_BYTES = 262144;

struct Args { const float* in[23]; float* out; unsigned char* ws; int ph_lo, ph_hi, li, pad; };
typedef const __attribute__((address_space(4))) Args* ArgsP;
__device__ __forceinline__ ArgsP args_ptr() { ArgsP p = (ArgsP)__builtin_amdgcn_kernarg_segment_ptr(); asm volatile("" : "+s"(p)); return p; }

#define XB_TMO      128
#define XB_XCNT(j)  (256  + 64 * (j))
#define XB_XSUB(j)  (1280 + 64 * (j))
#define XB_XGEN(j)  (2304 + 64 * (j))
#define XB_TOP      3328
#define XB_TOPGEN   3392
#define XCD_BAR_WORDS 3456
#define XB_SPIN_CAP (1u << 18)

__device__ __forceinline__ unsigned xb_ld(unsigned* p)              { return __hip_atomic_load(p, __ATOMIC_RELAXED, __HIP_MEMORY_SCOPE_AGENT); }
__device__ __forceinline__ unsigned xb_add(unsigned* p, unsigned v) { return __hip_atomic_fetch_add(p, v, __ATOMIC_RELAXED, __HIP_MEMORY_SCOPE_AGENT); }
__device__ __forceinline__ unsigned xb_xcc_id() { return (unsigned)__builtin_amdgcn_s_getreg((3 << 11) | 20) & 0xFu; }
#define XB_SPIN(cond, bar) do { unsigned _sp = 0; while (cond) { __builtin_amdgcn_s_sleep(1); \
    if ((++_sp & 255u) == 0u) { if (xb_ld(&(bar)[XB_TMO])) break; if (_sp > XB_SPIN_CAP) { atomicAdd(&(bar)[XB_TMO], 1u); break; } } } } while (0)

struct XcdBarrier {
    unsigned* bar; unsigned x;
    volatile LAS unsigned* st;
};

__device__ __forceinline__ XcdBarrier xcd_barrier_post(unsigned* bar, volatile LAS unsigned* st) {
    XcdBarrier b; b.bar = bar; b.x = xb_xcc_id(); b.st = st;
    if (threadIdx.x == 0) (void)xb_add(&bar[XB_XCNT(b.x)], 1u);
    return b;
}
__device__ __forceinline__ void xcd_barrier_complete(unsigned* bar, unsigned x, unsigned& nloc, unsigned& nx) {
    const unsigned G = gridDim.x * gridDim.y * gridDim.z;
    unsigned sum, cnt, mine, sp = 0u;
    for (;;) {
        sum = 0u; cnt = 0u; mine = 0u;
#pragma unroll
        for (unsigned j = 0; j < 16; ++j) { const unsigned c = xb_ld(&bar[XB_XCNT(j)]); sum += c; cnt += (c > 0u) ? 1u : 0u; mine = (j == x) ? c : mine; }
        if (sum == G) break;
        __builtin_amdgcn_s_sleep(1);
        if ((++sp & 255u) == 0u) { if (xb_ld(&bar[XB_TMO])) break; if (sp > XB_SPIN_CAP) { atomicAdd(&bar[XB_TMO], 1u); break; } }
    }
    nloc = mine > 0u ? mine : 1u; nx = cnt > 0u ? cnt : 1u;
}

__device__ __forceinline__ void xcd_barrier(const XcdBarrier& b) {
    asm volatile("s_waitcnt vmcnt(0)" ::: "memory");
    __syncthreads();
    if (threadIdx.x == 0) {
        unsigned* bar = b.bar;
        __builtin_amdgcn_s_waitcnt(0);
        unsigned nloc = b.st[0], nx = b.st[1];
        if (nloc == 0u) { xcd_barrier_complete(bar, b.x, nloc, nx); b.st[0] = nloc; b.st[1] = nx; }
        const unsigned old = xb_add(&bar[XB_XSUB(b.x)], 1u);
        const unsigned gen = old / nloc;
        if (old + 1u == (gen + 1u) * nloc) {
            __builtin_amdgcn_fence(__ATOMIC_RELEASE, "agent");
            asm volatile("s_waitcnt vmcnt(0)" ::: "memory");
            const unsigned og = xb_add(&bar[XB_TOP], 1u);
            const unsigned tg = og / nx;
            if (og + 1u == (tg + 1u) * nx) xb_add(&bar[XB_TOPGEN], 1u);
            else XB_SPIN(xb_ld(&bar[XB_TOPGEN]) == tg, bar);
            __builtin_amdgcn_fence(__ATOMIC_ACQUIRE, "agent");
            xb_add(&bar[XB_XGEN(b.x)], 1u);
            asm volatile("s_waitcnt vmcnt(0)" ::: "memory");
        } else {
            XB_SPIN(xb_ld(&bar[XB_XGEN(b.x)]) == gen, bar);
            __builtin_amdgcn_fence(__ATOMIC_ACQUIRE, "agent");
            asm volatile("s_waitcnt vmcnt(0)" ::: "memory");
        }
    }
    __syncthreads();
}

__device__ __forceinline__ float bf_lo(unsigned w) { return __uint_as_float(w << 16); }
__device__ __forceinline__ float bf_hi(unsigned w) { return __uint_as_float(w & 0xffff0000u); }
__device__ __forceinline__ float bf2f(bf16_t b) { return __uint_as_float(((unsigned)b) << 16); }
typedef __bf16 bf16x2_t __attribute__((ext_vector_type(2)));
__device__ __forceinline__ unsigned pkbf(float lo, float hi) { const f32x2 v = {lo, hi}; const bf16x2_t b = __builtin_convertvector(v, bf16x2_t); return __builtin_bit_cast(unsigned, b); }
__device__ __forceinline__ bf16_t f2bf(float f) { return (bf16_t)(pkbf(f, 0.f) & 0xffffu); }
__device__ __forceinline__ float wave_sum(float v) {
#pragma unroll
    for (int o = 1; o < 64; o <<= 1) v += __shfl_xor(v, o);
    return v;
}
__device__ __forceinline__ float wave_max(float v) {
#pragma unroll
    for (int o = 1; o < 64; o <<= 1) v = fmaxf(v, __shfl_xor(v, o));
    return v;
}
__device__ __forceinline__ float sigmoidf_fast(float x) { return __builtin_amdgcn_rcpf(1.0f + __builtin_amdgcn_exp2f(-1.4426950408889634f * x)); }
__device__ __forceinline__ float gelu_erf(float x) { return 0.5f * x * (1.0f + erff(x * 0.70710678118654752f)); }
__device__ __forceinline__ int t5_bucket(int d) {
    const int n = d > 0 ? d : 0;
    if (n < 16) return n;
    const float v = logf((float)n * (1.0f / 16.0f)) / 4.1588830833596715f * 16.0f;
    int b = 16 + (int)(v + 1e-5f);
    return b < 31 ? b : 31;
}

__device__ __forceinline__ void p0_transpose_item(const float* __restrict__ W, int K, int N, bf16_t* WT, int row_off, LAS float* scr, int item, int lane, int ldk = 0, int koff = 0) {
    const int nblk = N / 32, kb = item / nblk, nb = item % nblk, k0 = 64 * kb, n0 = 32 * nb;
#pragma unroll 8
    for (int i = 0; i < 32; ++i) { const int kk = 2 * i + (lane >> 5); scr[kk * 33 + (lane & 31)] = W[(size_t)(k0 + kk) * N + n0 + (lane & 31)]; }
    asm volatile("s_waitcnt lgkmcnt(0)" ::: "memory");
    const int c = lane & 7;
#pragma unroll
    for (int j = 0; j < 4; ++j) { const int n = (lane >> 3) + 8 * j; const LAS float* s = scr + (8 * c) * 33 + n;
        u32x4 o; o.x = pkbf(s[0 * 33], s[1 * 33]); o.y = pkbf(s[2 * 33], s[3 * 33]); o.z = pkbf(s[4 * 33], s[5 * 33]); o.w = pkbf(s[6 * 33], s[7 * 33]);
        *(u32x4*)(WT + (size_t)(row_off + n0 + n) * (ldk ? ldk : K) + koff + k0 + 8 * c) = o; }
    asm volatile("s_waitcnt lgkmcnt(0)" ::: "memory");
}
constexpr float WIN_SCALE = 64.0f;
__device__ __forceinline__ void p0_transpose_item_f8(const float* __restrict__ W, int K, int N, unsigned char* WT, float scale, LAS float* scr, int item, int lane) {
    const int nblk = N / 32, kb = item / nblk, nb = item % nblk, k0 = 64 * kb, n0 = 32 * nb;
#pragma unroll 8
    for (int i = 0; i < 32; ++i) { const int kk = 2 * i + (lane >> 5); scr[kk * 33 + (lane & 31)] = W[(size_t)(k0 + kk) * N + n0 + (lane & 31)]; }
    asm volatile("s_waitcnt lgkmcnt(0)" ::: "memory");
    const int c = lane & 7;
#pragma unroll
    for (int j = 0; j < 4; ++j) { const int n = (lane >> 3) + 8 * j; const LAS float* s = scr + (8 * c) * 33 + n;
        int p0 = __builtin_amdgcn_cvt_pk_fp8_f32(s[0 * 33] * scale, s[1 * 33] * scale, 0, false); p0 = __builtin_amdgcn_cvt_pk_fp8_f32(s[2 * 33] * scale, s[3 * 33] * scale, p0, true);
        int p1 = __builtin_amdgcn_cvt_pk_fp8_f32(s[4 * 33] * scale, s[5 * 33] * scale, 0, false); p1 = __builtin_amdgcn_cvt_pk_fp8_f32(s[6 * 33] * scale, s[7 * 33] * scale, p1, true);
        *(u32x2*)(WT + (size_t)(n0 + n) * K + k0 + 8 * c) = (u32x2){(unsigned)p0, (unsigned)p1}; }
    asm volatile("s_waitcnt lgkmcnt(0)" ::: "memory");
}
__device__ __forceinline__ void cvt_stream(const float* __restrict__ src, bf16_t* dst, size_t n8, size_t gtid, size_t gthreads, int s_lo = 0, int s_hi = 1 << 30) {
    for (size_t i = gtid + (size_t)s_lo * gthreads; i < n8 && i < gtid + (size_t)s_hi * gthreads; i += gthreads) {
        const f32x4 a = *(const f32x4*)(src + i * 8), b = *(const f32x4*)(src + i * 8 + 4);
        u32x4 o; o.x = pkbf(a[0], a[1]); o.y = pkbf(a[2], a[3]); o.z = pkbf(b[0], b[1]); o.w = pkbf(b[2], b[3]);
        *(u32x4*)(dst + i * 8) = o;
    }
}
constexpr float PEER_U_SCALE = 800.0f, PEER_H_SCALE = 20.0f, PEER_V_SCALE = 16.0f;
__device__ __forceinline__ unsigned pack_i8x4(f32x4 v) {
    int q[4];
#pragma unroll
    for (int i = 0; i < 4; ++i) { int t = (int)__builtin_rintf(v[i]); t = t < -127 ? -127 : (t > 127 ? 127 : t); q[i] = t & 0xff; }
    return (unsigned)(q[0] | (q[1] << 8) | (q[2] << 16) | (q[3] << 24));
}
__device__ __forceinline__ void cvt_stream_i8(const float* __restrict__ src, unsigned char* dst, size_t n16, float scale, size_t gtid, size_t gthreads, int s_lo = 0, int s_hi = 1 << 30) {
    for (size_t i = gtid + (size_t)s_lo * gthreads; i < n16 && i < gtid + (size_t)s_hi * gthreads; i += gthreads) { u32x4 o;
#pragma unroll
        for (int q = 0; q < 4; ++q) o[q] = pack_i8x4(*(const f32x4*)(src + i * 16 + q * 4) * scale);
        *(u32x4*)(dst + ((((i & 63) >> 3) * (size_t)16384 + (i >> 6)) * 128 + (i & 7) * 16)) = o; }
}
template <bool SLAB = true> __device__ __forceinline__ void cvt_stream_fp8(const float* __restrict__ src, unsigned char* dst, size_t n16, float scale, size_t gtid, size_t gthreads, int s_lo = 0, int s_hi = 1 << 30) {
    for (size_t i = gtid + (size_t)s_lo * gthreads; i < n16 && i < gtid + (size_t)s_hi * gthreads; i += gthreads) { u32x4 o;
#pragma unroll
        for (int q = 0; q < 4; ++q) { const f32x4 v = *(const f32x4*)(src + i * 16 + q * 4) * scale; int p = __builtin_amdgcn_cvt_pk_fp8_f32(v[0], v[1], 0, false); p = __builtin_amdgcn_cvt_pk_fp8_f32(v[2], v[3], p, true); o[q] = (unsigned)p; }
        *(u32x4*)(dst + (SLAB ? ((((i & 63) >> 3) * (size_t)16384 + (i >> 6)) * 128 + (i & 7) * 16) : i * 16)) = o; }
}
__device__ __forceinline__ void peer_tables(ArgsP a, int tid, int s_lo, int s_hi) {
    unsigned char* ws = a->ws; const size_t gtid = (size_t)blockIdx.x * NTHR + tid, gth = (size_t)gridDim.x * NTHR;
    cvt_stream_i8(a->in[16], ws + WS_PU, (size_t)16384 * 1024 / 16, PEER_U_SCALE, gtid, gth, s_lo, s_hi);
    cvt_stream_fp8(a->in[17], ws + WS_PV, (size_t)16384 * 1024 / 16, PEER_V_SCALE, gtid, gth, s_lo, s_hi);
}
__device__ __forceinline__ void phase0(ArgsP a, LAS unsigned char* lds, int tid, int lane, int wave) {
    unsigned char* ws = a->ws;
    const int G = gridDim.x, gw = blockIdx.x * NWAVES + wave, NGW = G * NWAVES;
    {   LAS float* scr = (LAS float*)(lds + wave * 16384);
        constexpr int I_IN = (1024 / 64) * (7168 / 32);
        for (int it = gw; it < I_IN; it += NGW) p0_transpose_item_f8(a->in[2], 1024, 7168, ws + WS_WIN_T, WIN_SCALE, scr, it, lane);
    }
    {   const size_t gtid = (size_t)blockIdx.x * NTHR + tid, gth = (size_t)G * NTHR;
        cvt_stream_fp8<false>(a->in[0], ws + WS_R0, (size_t)T_TOK * DM / 16, 1.0f, gtid, gth);
    }
}
__device__ __forceinline__ void phase0_deferred(ArgsP a, LAS unsigned char* lds, int tid, int lane, int wave, int part, int cls) {
    unsigned char* ws = a->ws;
    const int G = gridDim.x, gw = blockIdx.x * NWAVES + wave, NGW = G * NWAVES;
    const size_t gtid = (size_t)blockIdx.x * NTHR + tid, gth = (size_t)G * NTHR;
    const int nstep = (int)(((size_t)16384 * 1024 / 16 + gth - 1) / gth);
    const int cut = nstep * cls / 8, s_lo = part ? cut : 0, s_hi = part ? nstep : cut;
    cvt_stream(a->in[1], (bf16_t*)(ws + WS_PB16), (size_t)T_TOK * 256 / 8, gtid, gth, s_lo, s_hi);
    peer_tables(a, tid, s_lo, s_hi);
    if ((cls >= 4) != (part == 0)) return;
    __syncthreads();
    {
        LAS float* scr = (LAS float*)(lds + wave * 16384);
        constexpr int I_SQ = (1024 / 64) * (1024 / 32), I_PLE = (256 / 64) * (1024 / 32);
        constexpr int NIT = 4 * I_SQ + I_PLE;
        for (int it = gw; it < NIT; it += NGW) {
            int r = it;
            if (r < I_SQ) { p0_transpose_item(a->in[8], 1024, 1024, (bf16_t*)(ws + WS_PA_T), 0, scr, r, lane); continue; } r -= I_SQ;
            if (r < I_SQ) { p0_transpose_item(a->in[9], 1024, 1024, (bf16_t*)(ws + WS_PB_T), 0, scr, r, lane); continue; } r -= I_SQ;
            if (r < I_SQ) { p0_transpose_item(a->in[10], 1024, 1024, (bf16_t*)(ws + WS_WOUT_T), 0, scr, r, lane); continue; } r -= I_SQ;
            if (r < I_SQ) { p0_transpose_item(a->in[19], 1024, 1024, (bf16_t*)(ws + WS_WQ2_T), 2048, scr, r, lane); continue; } r -= I_SQ;
            p0_transpose_item(a->in[18], 256, 1024, (bf16_t*)(ws + WS_WPLE_T), 0, scr, r, lane);
        }
    }
    __syncthreads();
    {
        LAS float* sk = (LAS float*)lds;
        LAS float* wq = sk + 128 * 132;
        const float* WQ = a->in[14]; const float* SK = a->in[15]; bf16_t* W2 = (bf16_t*)(ws + WS_WQ2_T);
        for (int item = blockIdx.x; item < 256; item += G) {
            const int hp = item >> 4, d0 = (item & 15) * 64, p = hp & 1;
#pragma unroll
            for (int i = 0; i < 8; ++i) { const int f = tid + 512 * i, n = f >> 5, k4 = f & 31; *(LAS f32x4*)(sk + n * 132 + k4 * 4) = *(const f32x4*)(SK + (size_t)p * 16384 + n * 128 + k4 * 4); }
#pragma unroll
            for (int i = 0; i < 4; ++i) { const int f = tid + 512 * i, dd = f >> 5, k4 = f & 31; *(LAS f32x4*)(wq + dd * 132 + k4 * 4) = *(const f32x4*)(WQ + (size_t)(d0 + dd) * 2048 + hp * 128 + k4 * 4); }
            __syncthreads();
            const int n = tid & 127, dg = tid >> 7;
            float acc[16];
#pragma unroll
            for (int j = 0; j < 16; ++j) acc[j] = 0.f;
            for (int k = 0; k < 128; k += 4) { const f32x4 s = *(const LAS f32x4*)(sk + n * 132 + k);
#pragma unroll
                for (int j = 0; j < 16; ++j) { const f32x4 w = *(const LAS f32x4*)(wq + (dg * 16 + j) * 132 + k); acc[j] += (s[0] * w[0] + s[1] * w[1]) + (s[2] * w[2] + s[3] * w[3]); } }
            u32x4 o0, o1;
            o0.x = pkbf(acc[0], acc[1]); o0.y = pkbf(acc[2], acc[3]); o0.z = pkbf(acc[4], acc[5]); o0.w = pkbf(acc[6], acc[7]);
            o1.x = pkbf(acc[8], acc[9]); o1.y = pkbf(acc[10], acc[11]); o1.z = pkbf(acc[12], acc[13]); o1.w = pkbf(acc[14], acc[15]);
            bf16_t* dst = W2 + (size_t)(hp * 128 + n) * 1024 + d0 + dg * 16;
            *(u32x4*)dst = o0; *(u32x4*)(dst + 8) = o1;
            __syncthreads();
        }
    }
    {
        float* lut = (float*)(ws + WS_LUT); const float* rb = a->in[13];
        for (size_t i = gtid; i < (size_t)NHEAD * LUTN; i += gth) { const int h = (int)(i / LUTN), j = (int)(i % LUTN); lut[i] = rb[t5_bucket(j - LUT_OFF) * NHEAD + h]; }
    }
    __syncthreads();
}

template <int ND> __device__ __forceinline__ void store_line_pair(unsigned char* base, unsigned off, unsigned pitch8, u32x4 w0, u32x4 w1, bool hiF) {
    u32x4 vA, vB;
#pragma unroll
    for (int j = 0; j < ND; ++j) { const unsigned send = hiF ? w0[j] : w1[j]; const unsigned recv = (unsigned)__builtin_amdgcn_mov_dpp((int)send, 0x128, 0xF, 0xF, true);
        vA[j] = hiF ? recv : w0[j]; vB[j] = hiF ? w1[j] : recv; }
    if (ND == 4) { __builtin_nontemporal_store(vA, (u32x4*)(base + off)); __builtin_nontemporal_store(vB, (u32x4*)(base + (off + pitch8))); }
    else { __builtin_nontemporal_store((u32x2){vA[0], vA[1]}, (u32x2*)(base + off)); __builtin_nontemporal_store((u32x2){vB[0], vB[1]}, (u32x2*)(base + (off + pitch8))); }
}
struct EpiZ {
    static constexpr bool PERM = true, AFTER_DRAIN = false, HAS_MID = false;
    bf16_t* w5; bf16_t* g2; const float* bias; float ascale;
    __device__ __forceinline__ void run(const int ACT, const bool KS, const f32x4 (&acc)[2][2][4][2], bf16_t* base, int pm, int colt, int bcolt, int wr, int wc, int fr, int fq) const {
        const int row0 = pm * 256 + wr * 64 + fr, col0 = colt + wc * 64 + 8 * fq, bcol0 = bcolt + wc * 64 + 8 * fq;
        const bool hiF = (fr & 8) != 0; const int rowp = pm * 256 + wr * 64 + (fr & 7), colp = col0 + (hiF ? 32 : 0);
        const f32x4 b00 = *(const f32x4*)(bias + bcol0), b01 = *(const f32x4*)(bias + bcol0 + 4), b10 = *(const f32x4*)(bias + bcol0 + 32), b11 = *(const f32x4*)(bias + bcol0 + 36);
#pragma unroll
        for (int ai = 0; ai < 2; ++ai)
#pragma unroll
            for (int m = 0; m < 4; ++m) { u32x4 w[2];
#pragma unroll
                for (int bj = 0; bj < 2; ++bj) {
                    f32x4 v0 = acc[ai][bj][m][0] * ascale + (bj ? b10 : b00), v1 = acc[ai][bj][m][1] * ascale + (bj ? b11 : b01);
                    if (ACT == 1) { const f32x2 a = pg8::gelu_pk((f32x2){v0[0], v0[1]}), b = pg8::gelu_pk((f32x2){v0[2], v0[3]}), c = pg8::gelu_pk((f32x2){v1[0], v1[1]}), d = pg8::gelu_pk((f32x2){v1[2], v1[3]});
                        v0 = (f32x4){a.x, a.y, b.x, b.y}; v1 = (f32x4){c.x, c.y, d.x, d.y}; }
                    if (ACT == 2) {
                        unsigned q0 = 0, q1 = 0;
#pragma unroll
                        for (int j = 0; j < 4; ++j) { int t0 = (int)(sigmoidf_fast(v0[j]) * 255.0f + 0.5f), t1 = (int)(sigmoidf_fast(v1[j]) * 255.0f + 0.5f);
                            t0 = t0 < 1 ? 1 : (t0 > 255 ? 255 : t0); t1 = t1 < 1 ? 1 : (t1 > 255 ? 255 : t1); q0 |= (unsigned)t0 << (8 * j); q1 |= (unsigned)t1 << (8 * j); }
                        w[bj].x = q0; w[bj].y = q1; w[bj].z = 0u; w[bj].w = 0u;
                    } else { w[bj].x = pkbf(v0[0], v0[1]); w[bj].y = pkbf(v0[2], v0[3]); w[bj].z = pkbf(v1[0], v1[1]); w[bj].w = pkbf(v1[2], v1[3]); }
                }
                const unsigned eo = (unsigned)(rowp + ai * 128 + m * 16) * 1024u + (unsigned)colp;
                if (ACT == 2) store_line_pair<2>((unsigned char*)base, eo, 8u * 1024u, w[0], w[1], hiF);
                else store_line_pair<4>((unsigned char*)base, eo * 2u, 8u * 2048u, w[0], w[1], hiF);
            }
        if (KS) {
#pragma unroll
            for (int bj = 0; bj < 2; ++bj)
#pragma unroll
                for (int n = 0; n < 2; ++n) {
                    f32x4 cs = acc[0][bj][0][n];
#pragma unroll
                    for (int q = 1; q < 8; ++q) cs += acc[q >> 2][bj][q & 3][n];
                    cs = cs * ascale + *(const f32x4*)(bias + bcol0 + bj * 32 + 4 * n) * 8.0f;
#pragma unroll
                    for (int s = 1; s < 16; s <<= 1)
#pragma unroll
                        for (int j = 0; j < 4; ++j) cs[j] += __shfl_xor(cs[j], s);
                    if (fr == 0) *(f32x4*)((float*)((unsigned char*)w5 - WS_R1 + WS_KSUM) + (size_t)(2 * pm + wr) * 1024 + col0 + bj * 32 + 4 * n) = cs; }
        }
    }
    __device__ __forceinline__ void operator()(const f32x4 (&acc)[2][2][4][2], const pg8::Unit& u, int wr, int wc, int fr, int fq) const {
        const int t = u.pn >> 2, colt = (u.pn & 3) * 256, bcolt = u.pn * 256;
        bf16_t* base = (t < 5) ? w5 + (size_t)t * ((size_t)T_TOK * 1024) : (bf16_t*)((unsigned char*)g2 + (size_t)(t - 5) * ((size_t)T_TOK * 1024));
        run(t < 2 ? 1 : (t >= 5 ? 2 : 0), t == 3, acc, base, u.pm, colt, bcolt, wr, wc, fr, fq);
    }
};
template <int MODE> struct EpiMix {
    static constexpr bool PERM = true, AFTER_DRAIN = false, HAS_MID = false;
    bf16_t* out; const bf16_t* g1; const bf16_t* add;
    __device__ __forceinline__ void operator()(const f32x4 (&acc)[2][2][4][2], const pg8::Unit& u, int wr, int wc, int fr, int fq) const {
        const int row0 = u.pm * 256 + wr * 64 + fr, col0 = u.pn * 256 + wc * 64 + 8 * fq;
#pragma unroll
        for (int ai = 0; ai < 2; ++ai)
#pragma unroll
            for (int m = 0; m < 4; ++m) { const size_t ro = (size_t)(row0 + ai * 128 + m * 16) * 1024 + col0;
                u32x4 wq[2];
#pragma unroll
                for (int bj = 0; bj < 2; ++bj) { f32x4 v0 = acc[ai][bj][m][0], v1 = acc[ai][bj][m][1];
                    if (MODE >= 1) { const u32x4 g = *(const u32x4*)(g1 + ro + bj * 32);
                        v0[0] *= bf_lo(g.x); v0[1] *= bf_hi(g.x); v0[2] *= bf_lo(g.y); v0[3] *= bf_hi(g.y); v1[0] *= bf_lo(g.z); v1[1] *= bf_hi(g.z); v1[2] *= bf_lo(g.w); v1[3] *= bf_hi(g.w); }
                    if (MODE == 2) { const u32x4 g = *(const u32x4*)(add + ro + bj * 32);
                        v0[0] += bf_lo(g.x); v0[1] += bf_hi(g.x); v0[2] += bf_lo(g.y); v0[3] += bf_hi(g.y); v1[0] += bf_lo(g.z); v1[1] += bf_hi(g.z); v1[2] += bf_lo(g.w); v1[3] += bf_hi(g.w); }
                    wq[bj].x = pkbf(v0[0], v0[1]); wq[bj].y = pkbf(v0[2], v0[3]); wq[bj].z = pkbf(v1[0], v1[1]); wq[bj].w = pkbf(v1[2], v1[3]); }
                store_line_pair<4>((unsigned char*)out, ((unsigned)ro - (unsigned)(fr & 8) * 1020u) * 2u, 8u * 2048u, wq[0], wq[1], (fr & 8) != 0); }
    }
};
struct EpiNull { static constexpr bool PERM = true, AFTER_DRAIN = false, HAS_MID = false; float* sink;
    __device__ __forceinline__ void operator()(const f32x4 (&acc)[2][2][4][2], const pg8::Unit& u, int wr, int wc, int fr, int fq) const { float s = 0.f;
#pragma unroll
        for (int ai = 0; ai < 2; ++ai)
#pragma unroll
            for (int bj = 0; bj < 2; ++bj)
#pragma unroll
                for (int m = 0; m < 4; ++m) s += acc[ai][bj][m][0][0] + acc[ai][bj][m][1][3];
        if (s == 123.456f) sink[0] = s; } };
struct EpiGate {
    static constexpr bool PERM = true, AFTER_DRAIN = false, HAS_MID = true;
    bf16_t* out; const unsigned char* ga; const unsigned char* gb;
    __device__ __forceinline__ void operator()(f32x4 (&acc)[2][2][4][2], const pg8::Unit& u, int wr, int wc, int fr, int fq) const {
        const int row0 = u.pm * 256 + wr * 64 + fr, col0 = u.pn * 256 + wc * 64 + 8 * fq;
#define GB_(x_, k_) ((float)(((x_) >> (8 * (k_))) & 0xffu))
        if (u.half == 0) {
#pragma unroll
            for (int ai = 0; ai < 2; ++ai)
#pragma unroll
                for (int m = 0; m < 4; ++m) { const size_t ro = (size_t)(row0 + ai * 128 + m * 16) * 1024 + col0;
#pragma unroll
                    for (int bj = 0; bj < 2; ++bj) { const u32x2 a = *(const u32x2*)(ga + ro + bj * 32), b = *(const u32x2*)(gb + ro + bj * 32);
                        f32x4& v0 = acc[ai][bj][m][0]; f32x4& v1 = acc[ai][bj][m][1];
#pragma unroll
                        for (int j = 0; j < 4; ++j) { v0[j] *= GB_(a.x, j) * __builtin_amdgcn_rcpf(GB_(b.x, j)); v1[j] *= GB_(a.y, j) * __builtin_amdgcn_rcpf(GB_(b.y, j)); } } }
        } else {
#pragma unroll
            for (int ai = 0; ai < 2; ++ai)
#pragma unroll
                for (int m = 0; m < 4; ++m) { const size_t ro = (size_t)(row0 + ai * 128 + m * 16) * 1024 + col0;
                    u32x4 wq[2];
#pragma unroll
                    for (int bj = 0; bj < 2; ++bj) { const u32x2 g = *(const u32x2*)(gb + ro + bj * 32); const f32x4 v0 = acc[ai][bj][m][0] * (1.0f / 255.0f), v1 = acc[ai][bj][m][1] * (1.0f / 255.0f);
                        wq[bj].x = pkbf(v0[0] * GB_(g.x, 0), v0[1] * GB_(g.x, 1)); wq[bj].y = pkbf(v0[2] * GB_(g.x, 2), v0[3] * GB_(g.x, 3)); wq[bj].z = pkbf(v1[0] * GB_(g.y, 0), v1[1] * GB_(g.y, 1)); wq[bj].w = pkbf(v1[2] * GB_(g.y, 2), v1[3] * GB_(g.y, 3)); }
                    store_line_pair<4>((unsigned char*)out, ((unsigned)ro - (unsigned)(fr & 8) * 1020u) * 2u, 8u * 2048u, wq[0], wq[1], (fr & 8) != 0); }
        }
#undef GB_
    }
};
struct EpiRes {
    static constexpr bool PERM = true, AFTER_DRAIN = false, HAS_MID = false;
    const float* x; bf16_t* out;
    __device__ __forceinline__ void operator()(const f32x4 (&acc)[2][2][4][2], const pg8::Unit& u, int wr, int wc, int fr, int fq) const {
        const int row0 = u.pm * 256 + wr * 64 + fr, col0 = u.pn * 256 + wc * 64 + 8 * fq;
#pragma unroll
        for (int ai = 0; ai < 2; ++ai)
#pragma unroll
            for (int m = 0; m < 4; ++m) { const size_t ro = (size_t)(row0 + ai * 128 + m * 16) * 1024 + col0;
                u32x4 wq[2];
#pragma unroll
                for (int bj = 0; bj < 2; ++bj) {
                    const f32x4 v0 = *(const f32x4*)(x + ro + bj * 32) * ALPHA + acc[ai][bj][m][0], v1 = *(const f32x4*)(x + ro + bj * 32 + 4) * ALPHA + acc[ai][bj][m][1];
                    wq[bj].x = pkbf(v0[0], v0[1]); wq[bj].y = pkbf(v0[2], v0[3]); wq[bj].z = pkbf(v1[0], v1[1]); wq[bj].w = pkbf(v1[2], v1[3]); }
                store_line_pair<4>((unsigned char*)out, ((unsigned)ro - (unsigned)(fr & 8) * 1020u) * 2u, 8u * 2048u, wq[0], wq[1], (fr & 8) != 0); }
    }
};
struct EpiP6 {
    static constexpr bool PERM = true, AFTER_DRAIN = false, HAS_MID = false;
    float* sA; float* sB; bf16_t* e; const float* bpg;
    __device__ __forceinline__ void operator()(const f32x4 (&acc)[2][2][4][2], const pg8::Unit& u, int wr, int wc, int fr, int fq) const {
        const int row0 = u.pm * 256 + wr * 64 + fr;
        if (u.pn < 8) {
            _Float16* base = (_Float16*)((u.pn < 4) ? sA : sB); const int col0 = (u.pn & 3) * 256 + wc * 64 + 8 * fq;
#pragma unroll
            for (int ai = 0; ai < 2; ++ai)
#pragma unroll
                for (int m = 0; m < 4; ++m) { _Float16* rp = base + (size_t)(row0 + ai * 128 + m * 16) * 1024 + col0;
                    u32x4 wq[2];
#pragma unroll
                    for (int bj = 0; bj < 2; ++bj) { const f32x4 v0 = acc[ai][bj][m][0], v1 = acc[ai][bj][m][1];
#define H2_(x_, y_) __builtin_bit_cast(unsigned, __builtin_amdgcn_cvt_pkrtz(__builtin_fminf(__builtin_fmaxf((x_), -65000.0f), 65000.0f), __builtin_fminf(__builtin_fmaxf((y_), -65000.0f), 65000.0f)))
                        wq[bj].x = H2_(v0[0], v0[1]); wq[bj].y = H2_(v0[2], v0[3]); wq[bj].z = H2_(v1[0], v1[1]); wq[bj].w = H2_(v1[2], v1[3]);
#undef H2_
                    }
                    store_line_pair<4>((unsigned char*)base, ((unsigned)(rp - base) - (unsigned)(fr & 8) * 1020u) * 2u, 8u * 2048u, wq[0], wq[1], (fr & 8) != 0); }
        } else {
            const int col0 = (u.pn - 8) * 256 + wc * 64 + 8 * fq;
            f32x4 bv[2][2];
#pragma unroll
            for (int bj = 0; bj < 2; ++bj)
#pragma unroll
                for (int n = 0; n < 2; ++n) bv[bj][n] = *(const f32x4*)(bpg + col0 + bj * 32 + 4 * n);
#pragma unroll
            for (int ai = 0; ai < 2; ++ai)
#pragma unroll
                for (int m = 0; m < 4; ++m) { bf16_t* rp = e + (size_t)(row0 + ai * 128 + m * 16) * 1024 + col0; u32x4 wq[2];
#pragma unroll
                    for (int bj = 0; bj < 2; ++bj) { f32x4 v0 = acc[ai][bj][m][0] + bv[bj][0], v1 = acc[ai][bj][m][1] + bv[bj][1];
                        const u32x4 g = *(const u32x4*)(rp + bj * 32);
#pragma unroll
                        for (int j = 0; j < 4; ++j) { v0[j] = sigmoidf_fast(v0[j]); v1[j] = sigmoidf_fast(v1[j]); }
                        v0[0] *= bf_lo(g.x); v0[1] *= bf_hi(g.x); v0[2] *= bf_lo(g.y); v0[3] *= bf_hi(g.y); v1[0] *= bf_lo(g.z); v1[1] *= bf_hi(g.z); v1[2] *= bf_lo(g.w); v1[3] *= bf_hi(g.w);
                        wq[bj].x = pkbf(v0[0], v0[1]); wq[bj].y = pkbf(v0[2], v0[3]); wq[bj].z = pkbf(v1[0], v1[1]); wq[bj].w = pkbf(v1[2], v1[3]); }
                    store_line_pair<4>((unsigned char*)e, ((unsigned)(rp - e) - (unsigned)(fr & 8) * 1020u) * 2u, 8u * 2048u, wq[0], wq[1], (fr & 8) != 0); }
        }
    }
};

__device__ __forceinline__ void phase2(ArgsP a, LAS unsigned char* lds, int tid, int lane, int wave, bool dummy_out = false) {
    unsigned char* ws = a->ws;
    bf16_t* U = (bf16_t*)(ws + WS_R1); const bf16_t* V = (const bf16_t*)(ws + WS_R2);
    const float* lng = a->in[4]; const float* lnb = a->in[5]; const float* wsp = a->in[6]; const float* bs = a->in[7];
    LAS float* st_mean = (LAS float*)lds; LAS float* st_rstd = st_mean + 128;
    LAS bf16_t* Wt = (LAS bf16_t*)(lds + 1024);
    LAS bf16_t* VnT = Wt + 128 * 136;
    for (int ch = blockIdx.x; ch < T_TOK / 128; ch += gridDim.x) {
        const int t0 = ch * 128;
        for (int r = wave * 16; r < wave * 16 + 16; ++r) {
            const u32x4* vp = (const u32x4*)(V + (size_t)(t0 + r) * 1024) + lane * 2;
            const u32x4 q0 = vp[0], q1 = vp[1];
            float x[16];
            x[0] = bf_lo(q0.x); x[1] = bf_hi(q0.x); x[2] = bf_lo(q0.y); x[3] = bf_hi(q0.y); x[4] = bf_lo(q0.z); x[5] = bf_hi(q0.z); x[6] = bf_lo(q0.w); x[7] = bf_hi(q0.w);
            x[8] = bf_lo(q1.x); x[9] = bf_hi(q1.x); x[10] = bf_lo(q1.y); x[11] = bf_hi(q1.y); x[12] = bf_lo(q1.z); x[13] = bf_hi(q1.z); x[14] = bf_lo(q1.w); x[15] = bf_hi(q1.w);
            float s = 0.f;
#pragma unroll
            for (int j = 0; j < 16; ++j) s += x[j];
            const float mean = wave_sum(s) * (1.0f / 1024.0f);
            float ss = 0.f;
#pragma unroll
            for (int j = 0; j < 16; ++j) { const float d = x[j] - mean; ss += d * d; }
            const float rstd = 1.0f / sqrtf(wave_sum(ss) * (1.0f / 1024.0f) + LN_EPS);
            if (lane == 0) { st_mean[r] = mean; st_rstd[r] = rstd; }
        }
        __syncthreads();
        for (int g = 0; g < 8; ++g) {
            {
                const int trow = tid >> 2, s0 = (tid & 3) * 32; const float* wp = wsp + ((size_t)g * 128 + trow) * 128 + s0;
#pragma unroll
                for (int i = 0; i < 4; ++i) { const f32x4 f0 = *(const f32x4*)(wp + i * 8), f1 = *(const f32x4*)(wp + i * 8 + 4); const int sb = s0 + i * 8;
                    float w[8] = {f0[0], f0[1], f0[2], f0[3], f1[0], f1[1], f1[2], f1[3]};
#pragma unroll
                    for (int j = 0; j < 8; ++j) w[j] = (sb + j <= trow) ? w[j] : 0.f;
                    u32x4 o; o.x = pkbf(w[0], w[1]); o.y = pkbf(w[2], w[3]); o.z = pkbf(w[4], w[5]); o.w = pkbf(w[6], w[7]);
                    *(LAS u32x4*)(Wt + trow * 136 + sb) = o; }
            }
            {
                const int s = tid >> 2, c0 = (tid & 3) * 32; const float mean = st_mean[s], rstd = st_rstd[s];
                const u32x4* vp = (const u32x4*)(V + (size_t)(t0 + s) * 1024 + g * 128 + c0);
#pragma unroll
                for (int i = 0; i < 4; ++i) { const u32x4 q = vp[i]; const int cb = c0 + i * 8;
                    const f32x4 g0 = *(const f32x4*)(lng + g * 128 + cb), g1 = *(const f32x4*)(lng + g * 128 + cb + 4), b0 = *(const f32x4*)(lnb + g * 128 + cb), b1 = *(const f32x4*)(lnb + g * 128 + cb + 4);
                    float x[8] = {bf_lo(q.x), bf_hi(q.x), bf_lo(q.y), bf_hi(q.y), bf_lo(q.z), bf_hi(q.z), bf_lo(q.w), bf_hi(q.w)};
                    const float gg[8] = {g0[0], g0[1], g0[2], g0[3], g1[0], g1[1], g1[2], g1[3]}, bb[8] = {b0[0], b0[1], b0[2], b0[3], b1[0], b1[1], b1[2], b1[3]};
#pragma unroll
                    for (int j = 0; j < 8; ++j) VnT[(cb + j) * 136 + s] = f2bf((x[j] - mean) * rstd * gg[j] + bb[j]); }
            }
            __syncthreads();
            const int tt = wave >> 1, cc = wave & 1, i32 = lane & 31, kq = lane >> 5;
            f32x16 acc0 = {}, acc1 = {};
            for (int ks = 0; ks < 2 * (tt + 1); ++ks) {
                const bf16x8 af = *(const LAS bf16x8*)(Wt + (tt * 32 + i32) * 136 + ks * 16 + kq * 8);
                const bf16x8 b0 = *(const LAS bf16x8*)(VnT + (cc * 64 + i32) * 136 + ks * 16 + kq * 8);
                const bf16x8 b1 = *(const LAS bf16x8*)(VnT + (cc * 64 + 32 + i32) * 136 + ks * 16 + kq * 8);
                acc0 = __builtin_amdgcn_mfma_f32_32x32x16_bf16(af, b0, acc0, 0, 0, 0);
                acc1 = __builtin_amdgcn_mfma_f32_32x32x16_bf16(af, b1, acc1, 0, 0, 0);
            }
#pragma unroll
            for (int r = 0; r < 16; ++r) { const int trow = tt * 32 + (r & 3) + 8 * (r >> 2) + 4 * kq; const float bsv = bs[g * 128 + trow];
                const size_t off = (size_t)(t0 + trow) * 1024 + g * 128 + cc * 64 + i32;
                const float u0 = bf2f(U[off]), u1 = bf2f(U[off + 32]);
                bf16_t* Uo = dummy_out ? (bf16_t*)(ws + WS_END) + (size_t)trow * 1024 + g * 128 + cc * 64 + i32 : U + off;
                Uo[0] = f2bf(u0 * (acc0[r] + bsv)); Uo[32] = f2bf(u1 * (acc1[r] + bsv)); }
            __syncthreads();
        }
    }
}

__device__ __forceinline__ void phase3_naive(ArgsP a, LAS unsigned char* lds, int tid, int lane, int wave) {
    unsigned char* ws = a->ws;
    bf16_t* QO = (bf16_t*)(ws + WS_R3); const bf16_t* Kt = (const bf16_t*)(ws + WS_R4); const bf16_t* Vt = (const bf16_t*)(ws + WS_R5);
    const float* ksum = (const float*)(ws + WS_KSUM); const float* lut = (const float*)(ws + WS_LUT);
    LAS float* lg = (LAS float*)(lds + wave * 5120); LAS float* qs = lg + 1024;
    const int gw = blockIdx.x * NWAVES + wave, NGW = gridDim.x * NWAVES;
    for (int row = gw; row < NBATCH * NHEAD * SEQ; row += NGW) {
        const int t = row & (SEQ - 1), h = (row >> 12) & 7, b = row >> 15, qb = t >> 8;
        const size_t qoff = ((size_t)(b * SEQ + t)) * 1024 + h * 128 + 2 * lane;
        { const unsigned w = *(const unsigned*)(QO + qoff); qs[2 * lane] = bf_lo(w); qs[2 * lane + 1] = bf_hi(w); }
        asm volatile("s_waitcnt lgkmcnt(0)" ::: "memory");
        float gate = -__builtin_inff();
        if (lane < qb) { const float* k0 = ksum + ((size_t)(b * 32 + 2 * lane)) * 1024 + h * 128; const float* k1 = k0 + 1024; float s = 0.f;
            for (int d = 0; d < 128; ++d) s += qs[d] * ((k0[d] + k1[d]) * (1.0f / 256.0f));
            gate = s; }
        const int nsel = qb < 3 ? qb : 3; unsigned selmask = 0;
        for (int r = 0; r < nsel; ++r) { const float m = wave_max(gate); const unsigned long long bal = __ballot(gate == m); const int j = __ffsll((long long)bal) - 1; selmask |= 1u << j; if (lane == j) gate = -__builtin_inff(); }
        float mx = -__builtin_inff();
        { unsigned rem = selmask;
          for (int slot = 0; slot <= nsel; ++slot) { int blk, nkeys; if (slot == 0) { blk = qb; nkeys = (t & 255) + 1; } else { blk = __ffs(rem) - 1; rem &= rem - 1; nkeys = 256; }
            for (int kk = lane; kk < nkeys; kk += 64) { const int s = blk * 256 + kk; const u32x4* kp = (const u32x4*)(Kt + ((size_t)(b * SEQ + s)) * 1024 + h * 128); float dot = 0.f;
#pragma unroll 4
                for (int i = 0; i < 16; ++i) { const u32x4 w = kp[i]; const f32x4 qa = *(const LAS f32x4*)(qs + i * 8), qc = *(const LAS f32x4*)(qs + i * 8 + 4);
                    dot += bf_lo(w.x) * qa[0] + bf_hi(w.x) * qa[1] + bf_lo(w.y) * qa[2] + bf_hi(w.y) * qa[3] + bf_lo(w.z) * qc[0] + bf_hi(w.z) * qc[1] + bf_lo(w.w) * qc[2] + bf_hi(w.w) * qc[3]; }
                const int dd = t - s; const float l = dot * ATT_SCALE + lut[h * LUTN + (dd < 1023 ? dd : 1023) + LUT_OFF];   lg[slot * 256 + kk] = l; mx = fmaxf(mx, l); } } }
        mx = wave_max(mx);
        float sum = 0.f;
        for (int slot = 0; slot <= nsel; ++slot) { const int nkeys = slot == 0 ? (t & 255) + 1 : 256;
            for (int kk = lane; kk < nkeys; kk += 64) { const float e = __expf(lg[slot * 256 + kk] - mx); lg[slot * 256 + kk] = e; sum += e; } }
        sum = wave_sum(sum);
        asm volatile("s_waitcnt lgkmcnt(0)" ::: "memory");
        const float inv = 1.0f / sum; float o0 = 0.f, o1 = 0.f;
        { unsigned rem = selmask;
          for (int slot = 0; slot <= nsel; ++slot) { int blk, nkeys; if (slot == 0) { blk = qb; nkeys = (t & 255) + 1; } else { blk = __ffs(rem) - 1; rem &= rem - 1; nkeys = 256; }
            const bf16_t* vp = Vt + ((size_t)(b * SEQ + blk * 256)) * 1024 + h * 128 + 2 * lane;
            for (int kk = 0; kk < nkeys; ++kk) { const float w = lg[slot * 256 + kk]; const unsigned vv = *(const unsigned*)(vp + (size_t)kk * 1024); o0 += w * bf_lo(vv); o1 += w * bf_hi(vv); } } }
        *(unsigned*)(QO + qoff) = pkbf(o0 * inv, o1 * inv);
    }
}


#ifndef MK_NQR
#define MK_NQR 8
#endif
namespace attn {
constexpr int D = 128, PITCH = 1024;
constexpr float THR = 8.f; constexpr bool WSKIP = false;
constexpr float SCALE = 0.08838834764831845f;
constexpr int NW = 8, QBLK = 32, KVBLK = 64, QB = NW * QBLK;
constexpr int SHM_V = KVBLK * D * 2, SHM_K = KVBLK * D * 2;
constexpr int Q_LDS_OFF = 2 * SHM_V + 2 * SHM_K + NW * 64 * 4;
constexpr int LUT_LDS_OFF = Q_LDS_OFF + NW * 8192;
constexpr int SEL_LDS_OFF = LUT_LDS_OFF + LUTN * 4;
constexpr int LDS_NEED = SEL_LDS_OFF + QB * 4;
typedef short s16x4 __attribute__((ext_vector_type(4)));
template <class A, class Bt> struct same_t { static constexpr bool v = false; };
template <class A> struct same_t<A, A> { static constexpr bool v = true; };
__device__ __forceinline__ unsigned cvtpk(float lo, float hi) { return pkbf(lo, hi); }
#define KSWZ(row, colB) ((row) * 256 + ((colB) ^ (((row) & 7) << 4)))
#define SBAR() __builtin_amdgcn_sched_barrier(0)
__device__ __forceinline__ int v_st(int k, int c) { const int kk = (k & ~0xC) | ((k & 4) << 1) | ((k & 8) >> 1); return ((kk >> 3) * 4 + (c >> 5)) * 512 + ((kk & 7) * 32 + (c & 31)) * 2; }
__device__ __forceinline__ int v_rd_base(int lane) { return ((lane & 3) << 3) | (((lane >> 2) & 3) << 6) | (((lane >> 4) & 1) << 5) | (((lane >> 5) & 1) << 8); }
constexpr int v_rd_off(int d0, int ks, int half) { return d0 * 512 + ks * 4096 + half * 2048; }
__device__ __forceinline__ int crow(int r, int hi) { return (r & 3) + 8 * (r >> 2) + 4 * hi; }

__device__ __forceinline__ bf16x8 pack8(f32x4 a, f32x4 b) {
    u32x4 w = {cvtpk(a[0], a[1]), cvtpk(a[2], a[3]), cvtpk(b[0], b[1]), cvtpk(b[2], b[3])};
    return *reinterpret_cast<bf16x8*>(&w);
}
template <class T> __device__ __forceinline__ bf16x8 load8(const T* p) {
    if constexpr (same_t<T, float>::v) { return pack8(*(const f32x4*)p, *(const f32x4*)(p + 4)); }
    else { return *reinterpret_cast<const bf16x8*>(p); }
}
__device__ __forceinline__ void mask_tile(f32x16& p0, f32x16& p1, int dq, unsigned W) {
    const float NEG = -__builtin_inff();
#pragma unroll
    for (int r = 0; r < 16; ++r) {
        const int c = (r & 3) + 8 * (r >> 2);
        if ((unsigned)(dq - c) >= W) p0[r] = NEG;
        if ((unsigned)(dq - c - 32) >= W) p1[r] = NEG;
    }
}
__device__ __forceinline__ void bias_tile(f32x16& p0, f32x16& p1, const float* lp) {
#pragma unroll
    for (int g = 0; g < 4; ++g) { float b0[4], b1[4];
#pragma unroll
        for (int i = 0; i < 4; ++i) { const int r = 4 * g + i, c = (r & 3) + 8 * (r >> 2); b0[i] = lp[59 - c]; b1[i] = lp[59 - c - 32]; }
#pragma unroll
        for (int i = 0; i < 4; ++i) { p0[4 * g + i] += b0[i]; p1[4 * g + i] += b1[i]; }
        SBAR(); }
}
__device__ __forceinline__ void partialSM(f32x16& p0, f32x16& p1, float cst, float& m_reg, float& mn, float& alpha) {
    float pmax = p0[0]; for (int r = 1; r < 16; ++r) pmax = fmaxf(pmax, p0[r]); for (int r = 0; r < 16; ++r) pmax = fmaxf(pmax, p1[r]);
    { auto rr = __builtin_amdgcn_permlane32_swap(__float_as_uint(pmax), __float_as_uint(pmax), false, false);
      pmax = fmaxf(__uint_as_float(rr[0]), __uint_as_float(rr[1])); }
    pmax += cst;
    constexpr float C2 = 1.4426950408889634f * SCALE;
    if (__builtin_expect(__all((pmax - m_reg) * SCALE <= THR), 1)) { mn = m_reg; alpha = 1.f; }
    else { mn = fmaxf(m_reg, pmax); alpha = __builtin_amdgcn_exp2f((m_reg - mn) * C2); m_reg = mn; }
    const float mnL = (cst - mn) * C2;
    for (int r = 0; r < 16; ++r) p0[r] = fmaf(p0[r], C2, mnL); for (int r = 0; r < 16; ++r) p1[r] = fmaf(p1[r], C2, mnL);
    for (int r = 0; r < 16; ++r) p0[r] = __builtin_amdgcn_exp2f(p0[r]);
}
__device__ __forceinline__ void finishSM(f32x16& p0, f32x16& p1, float alpha, float& l_reg, bf16x8& pa0, bf16x8& pa1, bf16x8& pa2, bf16x8& pa3) {
    for (int r = 0; r < 16; ++r) p1[r] = __builtin_amdgcn_exp2f(p1[r]);
    float ps = 0; for (int r = 0; r < 16; ++r) ps += p0[r]; for (int r = 0; r < 16; ++r) ps += p1[r];
    { auto rr = __builtin_amdgcn_permlane32_swap(__float_as_uint(ps), __float_as_uint(ps), false, false);
      ps = __uint_as_float(rr[0]) + __uint_as_float(rr[1]); }
    l_reg = l_reg * alpha + ps;
#define PK4(P, B_, OUT) do { unsigned a0 = cvtpk(P[B_+0], P[B_+1]), a1 = cvtpk(P[B_+2], P[B_+3]);                          \
        unsigned b0 = cvtpk(P[B_+4], P[B_+5]), b1 = cvtpk(P[B_+6], P[B_+7]);                                             \
        auto r0 = __builtin_amdgcn_permlane32_swap(a0, b0, false, false); auto r1 = __builtin_amdgcn_permlane32_swap(a1, b1, false, false); \
        u32x4 w = {r0[0], r1[0], r0[1], r1[1]}; OUT = *reinterpret_cast<bf16x8*>(&w); } while (0)
    PK4(p0, 0, pa0); PK4(p0, 8, pa1); PK4(p1, 0, pa2); PK4(p1, 8, pa3);
#undef PK4
}
template <int KB, bool SK, int NQR = 0>
__device__ __forceinline__ void qkt(f32x16& p0, f32x16& p1, const char* K_lds, int r32, int hi, const char* Qw, bool act, const bf16x8* qr = nullptr) {
    if (SK && !act) { const float NEG = -__builtin_inff();
#pragma unroll
        for (int r = 0; r < 16; ++r) { p0[r] = NEG; p1[r] = NEG; } return; }
    p0 = f32x16{}; p1 = f32x16{};
    const char* kb[4];
#pragma unroll
    for (int dd = 0; dd < 4; ++dd) kb[dd] = K_lds + KB * SHM_K + KSWZ(r32, (dd * 16 + hi * 8) * 2);
#pragma unroll
    for (int d0 = 0; d0 < 8; ++d0) { const char* a = kb[d0 & 3] + (d0 >> 2) * 128;
        bf16x8 b0 = *reinterpret_cast<const bf16x8*>(a);
        bf16x8 b1 = *reinterpret_cast<const bf16x8*>(a + 32 * 256);
        const bf16x8 qf = (d0 < NQR) ? qr[d0] : *reinterpret_cast<const bf16x8*>(a - (K_lds + KB * SHM_K) + Qw);
        p0 = __builtin_amdgcn_mfma_f32_32x32x16_bf16(b0, qf, p0, 0, 0, 0);
        p1 = __builtin_amdgcn_mfma_f32_32x32x16_bf16(b1, qf, p1, 0, 0, 0); }
}
template <int VB, bool SK>
__device__ __forceinline__ void pv_tile(f32x16* o, int vb0, bf16x8 pa0, bf16x8 pa1, bf16x8 pa2, bf16x8 pa3, bool act) {
    if (SK && !act) return;
#define TRRD(dst, off) asm volatile("ds_read_b64_tr_b16 %0, %1 offset:%2" : "=&v"(dst) : "v"(vb0), "i"(off) : "memory")
#define PV_D0(d0) do { s16x4 l0, l1, l2, l3, h0, h1, h2, h3; constexpr int b_ = VB * SHM_V + v_rd_off(d0, 0, 0);     \
        TRRD(l0, b_); TRRD(h0, b_ + 2048); TRRD(l1, b_ + 4096); TRRD(h1, b_ + 6144); TRRD(l2, b_ + 8192); TRRD(h2, b_ + 10240); TRRD(l3, b_ + 12288); TRRD(h3, b_ + 14336); \
        asm volatile("s_waitcnt lgkmcnt(0)" ::: "memory"); SBAR();                 \
        o[d0] = __builtin_amdgcn_mfma_f32_32x32x16_bf16(pa0, (bf16x8){l0[0], l0[1], l0[2], l0[3], h0[0], h0[1], h0[2], h0[3]}, o[d0], 0, 0, 0);   \
        o[d0] = __builtin_amdgcn_mfma_f32_32x32x16_bf16(pa1, (bf16x8){l1[0], l1[1], l1[2], l1[3], h1[0], h1[1], h1[2], h1[3]}, o[d0], 0, 0, 0);   \
        o[d0] = __builtin_amdgcn_mfma_f32_32x32x16_bf16(pa2, (bf16x8){l2[0], l2[1], l2[2], l2[3], h2[0], h2[1], h2[2], h2[3]}, o[d0], 0, 0, 0);   \
        o[d0] = __builtin_amdgcn_mfma_f32_32x32x16_bf16(pa3, (bf16x8){l3[0], l3[1], l3[2], l3[3], h3[0], h3[1], h3[2], h3[3]}, o[d0], 0, 0, 0); } while (0)
    PV_D0(0); PV_D0(1); PV_D0(2); PV_D0(3);
#undef PV_D0
#undef TRRD
}

template <class TIn, class TOut> struct BlockRef { const TIn* Q; const TIn* K; const TIn* V; TOut* O; int P0; };
template <class TIn> struct Seam {
    bf16x8 qr[8];
    bf16x8 st_v0, st_v1, st_k0, st_k1; f32x4 sf0, sf1, sf2, sf3;
    f32x4 tq[16];
};
__device__ __forceinline__ int swa_jlo(int P0, int W) { const int lowk = P0 - W + 1; return lowk > 0 ? lowk / KVBLK : 0; }
#define ROW(p, k0, rr) ((p) + (size_t)((k0) + (rr)) * PITCH + sc)
#define VMW() asm volatile("s_waitcnt vmcnt(0)" ::: "memory")
#define VMWN(n) asm volatile("s_waitcnt vmcnt(%0)" :: "i"(n) : "memory")
#define SLOAD_H(Kp, Vp, k0) do { S.st_v0 = load8<TIn>(ROW(Vp, k0, sr)); S.st_v1 = load8<TIn>(ROW(Vp, k0, 32 + sr));              \
                         S.st_k0 = load8<TIn>(ROW(Kp, k0, sr)); S.st_k1 = load8<TIn>(ROW(Kp, k0, 32 + sr)); } while (0)
#define SWRITE_HK(bf) do { *(bf16x8*)(K_lds + (bf) * SHM_K + kws) = S.st_k0; *(bf16x8*)(K_lds + (bf) * SHM_K + kws + 32 * 256) = S.st_k1; } while (0)
#define SWRITE_HV(bf) do { *(bf16x8*)(V_lds + (bf) * SHM_V + vst0) = S.st_v0; *(bf16x8*)(V_lds + (bf) * SHM_V + vst1) = S.st_v1; } while (0)
#define SWRITE_H(bf) do { SWRITE_HV(bf); SWRITE_HK(bf); } while (0)
#define SLOAD_F(p, k0) do { S.sf0 = *(const f32x4*)ROW(p, k0, sr); S.sf1 = *(const f32x4*)(ROW(p, k0, sr) + 4);                \
                            S.sf2 = *(const f32x4*)ROW(p, k0, 32 + sr); S.sf3 = *(const f32x4*)(ROW(p, k0, 32 + sr) + 4); } while (0)
#define SWRITE_KF(bf) do { *(bf16x8*)(K_lds + (bf) * SHM_K + kws) = pack8(S.sf0, S.sf1); *(bf16x8*)(K_lds + (bf) * SHM_K + kws + 32 * 256) = pack8(S.sf2, S.sf3); } while (0)
#define SWRITE_VF(bf) do { *(bf16x8*)(V_lds + (bf) * SHM_V + vst0) = pack8(S.sf0, S.sf1); *(bf16x8*)(V_lds + (bf) * SHM_V + vst1) = pack8(S.sf2, S.sf3); } while (0)
template <class TIn, class TOut>
__device__ __forceinline__ void causal_swa_prime(const BlockRef<TIn, TOut>& cur, int W, char* lds, Seam<TIn>& S) {
    constexpr bool F32 = same_t<TIn, float>::v;
    const int tid = threadIdx.x, wid = __builtin_amdgcn_readfirstlane(tid >> 6), lane = tid & 63, r32 = lane & 31, hi = lane >> 5;
    const int sr = tid >> 4, sc = (tid & 15) * 8, kws = KSWZ(sr, sc * 2); char* K_lds = lds + 2 * SHM_V;
    const int kb0 = swa_jlo(cur.P0, W) * KVBLK;
    for (int d0 = 0; d0 < 8; ++d0) S.qr[d0] = load8<TIn>(cur.Q + (size_t)(wid * QBLK + r32) * PITCH + d0 * 16 + hi * 8);
    if constexpr (F32) { SLOAD_F((const float*)cur.K, kb0); VMW(); SWRITE_KF(0); SBAR(); SLOAD_F((const float*)cur.V, kb0); }
    else { SLOAD_H(cur.K, cur.V, kb0); VMW(); SWRITE_HK(0); }
    if (MK_NQR < 8) { char* Qw = lds + Q_LDS_OFF + wid * 8192; do { _Pragma("unroll") for (int d0_ = 0; d0_ < 8; ++d0_) *(bf16x8*)(Qw + KSWZ(r32, (d0_ * 16 + hi * 8) * 2)) = S.qr[d0_]; } while (0); }
    __syncthreads();
}
__device__ __forceinline__ unsigned moba_gate2(const bf16x8* qr, int P0, char* lds, const float* ksum, const float* lutg, bool newlut) {
    int tid_ = threadIdx.x; asm volatile("" : "+v"(tid_)); const int tid = tid_;
    char* kt = lds + 2 * SHM_V + SHM_K;
    {   const int j = tid >> 5, d4 = (tid & 31) * 4;
        const f32x4 s0 = *(const f32x4*)(ksum + (size_t)(2 * j) * 1024 + d4), s1 = *(const f32x4*)(ksum + (size_t)(2 * j + 1) * 1024 + d4);
        const f32x4 x = (s0 + s1) * (1.0f / 256.0f);
        const unsigned h0 = cvtpk(x[0], x[1]), h1 = cvtpk(x[2], x[3]);
        const unsigned l0 = cvtpk(x[0] - bf_lo(h0), x[1] - bf_hi(h0)), l1 = cvtpk(x[2] - bf_lo(h1), x[3] - bf_hi(h1));
        *(u32x2*)(kt + KSWZ(j, d4 * 2)) = (u32x2){h0, h1}; *(u32x2*)(kt + KSWZ(16 + j, d4 * 2)) = (u32x2){l0, l1};
        if (newlut) { float* lutl = (float*)(lds + LUT_LDS_OFF);
            for (int i = tid; i < LUTN; i += NW * 64) lutl[i] = lutg[i] * (1.0f / SCALE); }
    }
    __syncthreads();
    const int lane = tid & 63, r32 = lane & 31, hi = lane >> 5, qbI = P0 >> 8;
    f32x16 p = {};
#pragma unroll
    for (int d0 = 0; d0 < 8; ++d0) { const bf16x8 b0 = *reinterpret_cast<const bf16x8*>(kt + KSWZ(r32, ((d0 & 3) * 16 + hi * 8) * 2) + (d0 >> 2) * 128);
        p = __builtin_amdgcn_mfma_f32_32x32x16_bf16(b0, qr[d0], p, 0, 0, 0); }
    float bv0 = -__builtin_inff(), bv1 = bv0, bv2 = bv0; int bi0 = 0, bi1 = 0, bi2 = 0;
#define INS3(xv, xi) do { float x_ = (xv); int i_ = (xi); bool g_; float tv_; int ti_; \
        g_ = (x_ > bv0) || (x_ == bv0 && i_ < bi0); tv_ = g_ ? bv0 : x_; ti_ = g_ ? bi0 : i_; bv0 = g_ ? x_ : bv0; bi0 = g_ ? i_ : bi0; x_ = tv_; i_ = ti_; \
        g_ = (x_ > bv1) || (x_ == bv1 && i_ < bi1); tv_ = g_ ? bv1 : x_; ti_ = g_ ? bi1 : i_; bv1 = g_ ? x_ : bv1; bi1 = g_ ? i_ : bi1; x_ = tv_; i_ = ti_; \
        g_ = (x_ > bv2) || (x_ == bv2 && i_ < bi2); bv2 = g_ ? x_ : bv2; bi2 = g_ ? i_ : bi2; } while (0)
#pragma unroll
    for (int jj = 0; jj < 8; ++jj) { const int jb = (jj & 3) + 8 * (jj >> 2) + 4 * hi; INS3(jb < qbI ? p[jj] + p[jj + 8] : -__builtin_inff(), jb); }
    const float ov0 = __shfl_xor(bv0, 32), ov1 = __shfl_xor(bv1, 32), ov2 = __shfl_xor(bv2, 32); const int oi0 = __shfl_xor(bi0, 32), oi1 = __shfl_xor(bi1, 32), oi2 = __shfl_xor(bi2, 32);
    INS3(ov0, oi0); INS3(ov1, oi1); INS3(ov2, oi2);
#undef INS3
    unsigned selmask = 0;
    if (bv0 > -__builtin_inff()) selmask |= 1u << bi0; if (bv1 > -__builtin_inff()) selmask |= 1u << bi1; if (bv2 > -__builtin_inff()) selmask |= 1u << bi2;
    __syncthreads();
    return selmask;
}
template <class TIn, class TOut, int VAR = 0>
__device__ __forceinline__ void causal_swa_block(const BlockRef<TIn, TOut>& cur, const BlockRef<TIn, TOut>& nxt, int skv, int W, char* lds, Seam<TIn>& S, float farb, unsigned selmask_in) {
    constexpr bool F32 = same_t<TIn, float>::v;
    int tid_ = threadIdx.x; asm volatile("" : "+v"(tid_));
    const int tid = tid_, wid = __builtin_amdgcn_readfirstlane(tid >> 6), lane = tid & 63, r32 = lane & 31, hi = lane >> 5;
    const int j_lo = swa_jlo(cur.P0, W);
    int j_hi = (cur.P0 + QB - 1) / KVBLK + 1; if (j_hi > skv / KVBLK) j_hi = skv / KVBLK;
    const int NT = j_hi - j_lo;
    const int kbn = swa_jlo(nxt.P0, W) * KVBLK;
    const int qlo = cur.P0 + wid * QBLK, qm = qlo + r32 - 4 * hi;
    char* V_lds = lds; char* K_lds = lds + 2 * SHM_V; char* Qw = lds + Q_LDS_OFF + wid * 8192;
    float* ws = (float*)(lds + 2 * SHM_V + 2 * SHM_K) + wid * 64; float* li_l = ws, * al_l = ws + 32;
    float m_reg = -1e30f, l_reg = 0; f32x16 o[4] = {};
    const float* lutp = (const float*)(lds + LUT_LDS_OFF) + (qm + LUT_OFF - 59);
    const int sr = tid >> 4, sc = (tid & 15) * 8, vst0 = v_st(sr, sc), vst1 = v_st(32 + sr, sc), kws = KSWZ(sr, sc * 2);
    const int vb0 = (int)(uintptr_t)V_lds + v_rd_base(lane);
    const TIn* Kh = cur.K; const TIn* Vh = cur.V;
#define RESC(a) do { if (__any((a) < 1.f)) { if (hi == 0) al_l[r32] = (a); asm volatile("s_waitcnt lgkmcnt(0)" ::: "memory");              \
                     for (int d_ = 0; d_ < 4; ++d_) for (int r = 0; r < 16; ++r) o[d_][r] *= al_l[crow(r, hi)]; } } while (0)
#define KBASE(t) ((j_lo + (t)) * KVBLK)
#define ACT(t) (KBASE(t) <= qlo + QBLK - 1 && KBASE(t) + KVBLK - 1 >= qlo - W + 1)
#define BIAS_TILE(P0_, P1_, kb_) bias_tile(P0_, P1_, lutp - (kb_))
#define MASKT(P0_, P1_, t, cst_) do { const int kb_ = KBASE(t), jb_ = kb_ >> 8; float c_ = 0.f; if ((VAR != 1 && VAR != 3) && jb_ < (cur.P0 >> 8)) c_ = ((selmask >> jb_) & 1u) ? 0.f : -__builtin_inff(); \
        if ((VAR != 1 && VAR != 3) && qlo - kb_ - 63 >= 790) c_ += farb; else { if ((VAR != 1 && VAR != 3)) BIAS_TILE(P0_, P1_, kb_); if (kb_ + KVBLK - 1 > qlo) mask_tile(P0_, P1_, qm - kb_, (unsigned)W); } cst_ = c_; } while (0)
    constexpr int NQL = F32 ? 16 : 8;
    constexpr bool SK = WSKIP && !F32;
#define SEAM_K0() do { VMWN(NQL); if constexpr (F32) { SWRITE_KF(0); SBAR(); SLOAD_F((const float*)nxt.V, kbn); } else { SWRITE_HK(0); } SBAR(); } while (0)
    f32x16 pA0, pA1, pB0, pB1; float mnA, mnB, alA, alB, cA, cB; bf16x8 pa0, pa1, pa2, pa3;
    const unsigned selmask = selmask_in;
    if constexpr (F32) { VMW(); SWRITE_VF(0); SBAR(); } else { SWRITE_HV(0); SBAR(); }
    if (NT > 1) { if constexpr (F32) SLOAD_F((const float*)Kh, KBASE(1)); else SLOAD_H(Kh, Vh, KBASE(1)); }
    SBAR(); qkt<0, SK, (VAR == 3 ? 8 : MK_NQR)>(pA0, pA1, K_lds, r32, hi, Qw, ACT(0), S.qr);
    if constexpr (F32) { if (NT > 1) { VMW(); SWRITE_KF(1); SBAR(); SLOAD_F((const float*)Vh, KBASE(1)); } }
    MASKT(pA0, pA1, 0, cA); partialSM(pA0, pA1, cA, m_reg, mnA, alA);
    if (NT > 1) { VMW(); if constexpr (F32) { SWRITE_VF(1); SBAR(); if (NT > 2) SLOAD_F((const float*)Kh, KBASE(2)); } else SWRITE_H(1); }
    __syncthreads();
#define HALF_STEP(PX0, PX1, cX, mnX, alX, PY0, PY1, alY, t, KB, VB, SB) do {                                                      \
        SBAR(); qkt<KB, SK, (VAR == 3 ? 8 : MK_NQR)>(PX0, PX1, K_lds, r32, hi, Qw, ACT(t), S.qr);                                             \
        finishSM(PY0, PY1, alY, l_reg, pa0, pa1, pa2, pa3); SBAR();                                                           \
        if ((t) + 1 < NT) { if constexpr (F32) { VMW(); SWRITE_KF(SB); SBAR(); SLOAD_F((const float*)Vh, KBASE((t) + 1)); }  \
                            else { SLOAD_H(Kh, Vh, KBASE((t) + 1)); } SBAR(); }                                               \
        pv_tile<VB, SK>(o, vb0, pa0, pa1, pa2, pa3, ACT((t) - 1)); MASKT(PX0, PX1, (t), cX); partialSM(PX0, PX1, cX, m_reg, mnX, alX);                                        \
        __syncthreads();                                                                                                      \
        if ((t) + 1 < NT) { VMW(); if constexpr (F32) { SWRITE_VF(SB); SBAR(); if ((t) + 2 < NT) SLOAD_F((const float*)Kh, KBASE((t) + 2)); } \
                            else { SWRITE_H(SB); } }                                                                          \
        RESC(alX); __syncthreads(); } while (0)
    for (int t = 1; t + 1 < NT; t += 2) {
        HALF_STEP(pB0, pB1, cB, mnB, alB, pA0, pA1, alA, t, 1, 0, 0);
        HALF_STEP(pA0, pA1, cA, mnA, alA, pB0, pB1, alB, t + 1, 0, 1, 1);
    }
    const bool even = (NT & 1) == 0;
    if (even) { SBAR(); qkt<1, SK, (VAR == 3 ? 8 : MK_NQR)>(pB0, pB1, K_lds, r32, hi, Qw, ACT(NT - 1), S.qr); SBAR(); }
#define QROW(e) (nxt.Q + (size_t)(wid * QBLK + r32) * D + ((e) >> 1) * 16 + hi * 8 + ((e) & 1) * 4)
    if constexpr (F32) { SLOAD_F((const float*)nxt.K, kbn); SBAR();
#pragma unroll
        for (int e = 0; e < 8; ++e) S.tq[e] = *(const f32x4*)QROW(e); }
    else { SLOAD_H(nxt.K, nxt.V, kbn); SBAR();
#pragma unroll
        for (int d0 = 0; d0 < 8; ++d0) S.qr[d0] = load8<TIn>(nxt.Q + (size_t)(wid * QBLK + r32) * PITCH + d0 * 16 + hi * 8); }
    SBAR();
    finishSM(pA0, pA1, alA, l_reg, pa0, pa1, pa2, pa3); SBAR();
    if constexpr (F32) {
#pragma unroll
        for (int e = 8; e < 16; ++e) S.tq[e] = *(const f32x4*)QROW(e); SBAR(); }
#undef QROW
    pv_tile<0, SK>(o, vb0, pa0, pa1, pa2, pa3, ACT(even ? NT - 2 : NT - 1));
    if (even) { MASKT(pB0, pB1, NT - 1, cB); partialSM(pB0, pB1, cB, m_reg, mnB, alB); __syncthreads(); RESC(alB);
        finishSM(pB0, pB1, alB, l_reg, pa0, pa1, pa2, pa3); SBAR(); pv_tile<1, SK>(o, vb0, pa0, pa1, pa2, pa3, ACT(NT - 1)); }
    SBAR(); SEAM_K0(); VMW(); if (VAR != 3 && MK_NQR < 8) do { _Pragma("unroll") for (int d0_ = 0; d0_ < 8; ++d0_) *(bf16x8*)(Qw + KSWZ(r32, (d0_ * 16 + hi * 8) * 2)) = S.qr[d0_]; } while (0); SBAR();
    if (hi == 0) li_l[r32] = l_reg; asm volatile("s_waitcnt lgkmcnt(0)" ::: "memory");
    float rli[16];
#pragma unroll
    for (int r = 0; r < 16; ++r) rli[r] = __builtin_amdgcn_rcpf(li_l[crow(r, hi)]);
    TOut* Ow = cur.O + (size_t)(wid * QBLK) * PITCH;
#pragma unroll
    for (int r = 0; r < 16; ++r) { const int orow = crow(r, hi);
#pragma unroll
        for (int d0 = 0; d0 < 4; ++d0) { const float v = o[d0][r] * rli[r];
            if constexpr (same_t<TOut, float>::v) { Ow[(size_t)orow * D + d0 * 32 + r32] = v; }
            else { const float vn = __shfl_xor(v, 1);
                   if ((r32 & 1) == 0) *(unsigned*)(Ow + (size_t)orow * PITCH + d0 * 32 + r32) = cvtpk(v, vn); } } }
    if constexpr (F32) {
#pragma unroll
        for (int d0 = 0; d0 < 8; ++d0) S.qr[d0] = pack8(S.tq[2 * d0], S.tq[2 * d0 + 1]); }
    __syncthreads();
#undef RESC
#undef KBASE
#undef ACT
#undef MASKT
#undef BIAS_TILE
#undef SEAM_K0
#undef HALF_STEP
}
#undef ROW
#undef VMW
#undef VMWN
#undef SLOAD_H
#undef SWRITE_HK
#undef SWRITE_HV
#undef SWRITE_H
#undef SLOAD_F
#undef SWRITE_KF
#undef SWRITE_VF

}

template <int VAR = 0>
__device__ __forceinline__ void phase3_fast(ArgsP a, LAS unsigned char* lds_las, int tid, int lane, int wave, bool dummy_out = false) {
    unsigned char* ws = a->ws;
    bf16_t* QO = (bf16_t*)(ws + WS_R3); const bf16_t* Kt = (const bf16_t*)(ws + WS_R4); const bf16_t* Vt = (const bf16_t*)(ws + WS_R5);
    const float* ksum = (const float*)(ws + WS_KSUM); const float* lut = (const float*)(ws + WS_LUT); const float* rb = a->in[13];
    char* lds = (char*)lds_las;
    static_assert(attn::LDS_NEED <= LDS_BYTES, "attention LDS map");
    const int G = gridDim.x, bx = blockIdx.x, vcu = (G % 8 == 0) ? (bx % 8) * (G / 8) + bx / 8 : bx;
    constexpr int NITEM = NBATCH * NHEAD * 8;
    typedef attn::BlockRef<bf16_t, bf16_t> BR;
    auto ref = [&](int item, int pass) { const int bh = item >> 3, x = item & 7, b = bh >> 3, h = bh & 7, qb = pass ? 15 - x : x;
        BR r; const size_t base = (size_t)b * SEQ * 1024 + h * 128;
        r.Q = QO + base + (size_t)qb * 256 * 1024; r.O = dummy_out ? (bf16_t*)(ws + WS_END) + h * 128 : QO + base + (size_t)qb * 256 * 1024; r.K = Kt + base; r.V = Vt + base; r.P0 = qb * 256; return r; };
    int item = vcu * 2; if (item >= NITEM) return;
    int pass = 0; const int istride = G * 2;
    BR cur = ref(item, 0);
    attn::Seam<bf16_t> S; int hprev = -1;
    attn::causal_swa_prime<bf16_t, bf16_t>(cur, 1 << 30, lds, S);
    for (;;) {
        int itn = item, pn = pass + 1; bool last = false;
        if (pass == 1) { pn = 0; itn = item + 1; if ((itn & 1) == 0) itn = item - 1 + istride; if (itn >= NITEM) { last = true; itn = item; pn = pass; } }
        const BR nxt = last ? cur : ref(itn, pn);
        const int bh = item >> 3, b = bh >> 3, h = bh & 7;
        unsigned selmask = 0xffffu;
        if (VAR == 0) { selmask = attn::moba_gate2(S.qr, cur.P0, lds, ksum + (size_t)b * 32 * 1024 + h * 128, lut + h * LUTN, h != hprev); hprev = h; }
        attn::causal_swa_block<bf16_t, bf16_t, VAR>(cur, nxt, SEQ, 1 << 30, lds, S, rb[31 * NHEAD + h] * (1.0f / attn::SCALE), selmask);
        if (last) break;
        cur = nxt; item = itn; pass = pn;
    }
}
__device__ __forceinline__ void phase5b(ArgsP a, int lane, int wave) {
    unsigned char* ws = a->ws; const bf16_t* hp = (const bf16_t*)(ws + WS_R0); bf16_t* hb = (bf16_t*)(ws + WS_R3); unsigned* h8 = (unsigned*)(ws + WS_H8); const float* g = a->in[11]; const float* bb = a->in[12];
    const int gw = blockIdx.x * NWAVES + wave, NGW = gridDim.x * NWAVES;
    for (int m = gw; m < T_TOK; m += NGW) {
        f32x4 v[4]; float s = 0.f;
#pragma unroll
        for (int j = 0; j < 4; ++j) { const u32x2 w = *((const u32x2*)(hp + (size_t)m * 1024) + lane + 64 * j); v[j] = (f32x4){bf_lo(w.x), bf_hi(w.x), bf_lo(w.y), bf_hi(w.y)}; s += (v[j][0] + v[j][1]) + (v[j][2] + v[j][3]); }
        const float mean = wave_sum(s) * (1.f / 1024.f); float s2 = 0.f;
#pragma unroll
        for (int j = 0; j < 4; ++j) { v[j] = v[j] - mean; s2 += (v[j][0] * v[j][0] + v[j][1] * v[j][1]) + (v[j][2] * v[j][2] + v[j][3] * v[j][3]); }
        const float rstd = 1.f / sqrtf(wave_sum(s2) * (1.f / 1024.f) + LN_EPS);
        u32x2* o8 = (u32x2*)(hb + (size_t)m * 1024) + lane;
#pragma unroll
        for (int j = 0; j < 4; ++j) { const f32x4 gg = *((const f32x4*)g + lane + 64 * j), b4 = *((const f32x4*)bb + lane + 64 * j); const f32x4 y = v[j] * rstd * gg + b4;
            u32x2 w; w.x = pkbf(y[0], y[1]); w.y = pkbf(y[2], y[3]); o8[64 * j] = w;
            h8[((size_t)(2 * j + (lane >> 5)) * T_TOK + m) * 32 + (lane & 31)] = pack_i8x4(y * PEER_H_SCALE); }
    }
}
__device__ __forceinline__ void phase10(ArgsP a, int lane, int wave) {
    unsigned char* ws = a->ws; const bf16_t* hb = (const bf16_t*)(ws + WS_R3); const bf16_t* eb = (const bf16_t*)(ws + WS_R2); const bf16_t* f = (const bf16_t*)(ws + WS_R4);
    const float* g = a->in[21]; const float* bb = a->in[22]; float* out = a->out;
    const int gw = blockIdx.x * NWAVES + wave, NGW = gridDim.x * NWAVES;
    for (int m = gw; m < T_TOK; m += NGW) {
        f32x4 v[4]; float s = 0.f;
#pragma unroll
        for (int j = 0; j < 4; ++j) { const u32x2 hw = *((const u32x2*)(hb + (size_t)m * 1024) + lane + 64 * j), ew = *((const u32x2*)(eb + (size_t)m * 1024) + lane + 64 * j);
            const u32x2 fw = *((const u32x2*)(f + (size_t)m * 1024) + lane + 64 * j);
            v[j][0] = ALPHA * bf_lo(hw.x) + bf_lo(fw.x) + bf_lo(ew.x); v[j][1] = ALPHA * bf_hi(hw.x) + bf_hi(fw.x) + bf_hi(ew.x);
            v[j][2] = ALPHA * bf_lo(hw.y) + bf_lo(fw.y) + bf_lo(ew.y); v[j][3] = ALPHA * bf_hi(hw.y) + bf_hi(fw.y) + bf_hi(ew.y);
            s += (v[j][0] + v[j][1]) + (v[j][2] + v[j][3]); }
        const float mean = wave_sum(s) * (1.f / 1024.f); float s2 = 0.f;
#pragma unroll
        for (int j = 0; j < 4; ++j) { v[j] = v[j] - mean; s2 += (v[j][0] * v[j][0] + v[j][1] * v[j][1]) + (v[j][2] * v[j][2] + v[j][3] * v[j][3]); }
        const float rstd = 1.f / sqrtf(wave_sum(s2) * (1.f / 1024.f) + LN_EPS);
        f32x4* o = (f32x4*)(out + (size_t)m * 1024) + lane;
#pragma unroll
        for (int j = 0; j < 4; ++j) { const f32x4 gg = *((const f32x4*)g + lane + 64 * j), b4 = *((const f32x4*)bb + lane + 64 * j); o[64 * j] = v[j] * rstd * gg + b4; }
    }
}

__device__ __forceinline__ int tk_sortable(float v) { const int b = __float_as_int(v); return b ^ ((b >> 31) & 0x7fffffff); }
__device__ __forceinline__ float tk_value(int k, int mask) { const int s = k & ~mask; return __int_as_float(s ^ ((s >> 31) & 0x7fffffff)); }
#define TK_INS(K, key) do { int x_ = (key); _Pragma("unroll") for (int q_ = 0; q_ < 16; ++q_) { const int hi_ = max(K[q_], x_); x_ = min(K[q_], x_); K[q_] = hi_; } } while (0)
__device__ __forceinline__ void tk_sort16(int (&v)[16]) {
#define TK_CE(a_, b_) do { const int hi_ = max(v[a_], v[b_]), lo_ = min(v[a_], v[b_]); v[a_] = hi_; v[b_] = lo_; } while (0)
    TK_CE(0, 13); TK_CE(1, 12); TK_CE(2, 15); TK_CE(3, 14); TK_CE(4, 8); TK_CE(5, 6); TK_CE(7, 11); TK_CE(9, 10);
    TK_CE(0, 5); TK_CE(1, 7); TK_CE(2, 9); TK_CE(3, 4); TK_CE(6, 13); TK_CE(8, 14); TK_CE(10, 15); TK_CE(11, 12);
    TK_CE(0, 1); TK_CE(2, 3); TK_CE(4, 5); TK_CE(6, 8); TK_CE(7, 9); TK_CE(10, 11); TK_CE(12, 13); TK_CE(14, 15);
    TK_CE(0, 2); TK_CE(1, 3); TK_CE(4, 10); TK_CE(5, 11); TK_CE(6, 7); TK_CE(8, 9); TK_CE(12, 14); TK_CE(13, 15);
    TK_CE(1, 2); TK_CE(3, 12); TK_CE(4, 6); TK_CE(5, 7); TK_CE(8, 10); TK_CE(9, 11); TK_CE(13, 14);
    TK_CE(1, 4); TK_CE(2, 6); TK_CE(5, 8); TK_CE(7, 10); TK_CE(9, 13); TK_CE(11, 14);
    TK_CE(2, 4); TK_CE(3, 6); TK_CE(9, 12); TK_CE(11, 13);
    TK_CE(3, 5); TK_CE(6, 8); TK_CE(7, 9); TK_CE(10, 12);
    TK_CE(3, 4); TK_CE(5, 6); TK_CE(7, 8); TK_CE(9, 10); TK_CE(11, 12);
    TK_CE(6, 7); TK_CE(8, 9);
#undef TK_CE
}
__device__ __forceinline__ void tk_merge16(int (&K)[16], int (&B)[16]) {
#pragma unroll
    for (int i = 0; i < 16; ++i) K[i] = max(K[i], B[15 - i]);
#pragma unroll
    for (int j = 8; j > 0; j >>= 1)
#pragma unroll
        for (int i = 0; i < 16; ++i) { const int l = i ^ j; if (l > i) { const int hi = max(K[i], K[l]), lo = min(K[i], K[l]); K[i] = hi; K[l] = lo; } }
}
__device__ __forceinline__ float h16_lo(unsigned x) { return (float)__builtin_bit_cast(_Float16, (unsigned short)(x & 0xffffu)); }
__device__ __forceinline__ float h16_hi(unsigned x) { return (float)__builtin_bit_cast(_Float16, (unsigned short)(x >> 16)); }
typedef short s16x2_t __attribute__((ext_vector_type(2)));
__device__ __forceinline__ unsigned tk_sortable16x2(unsigned x) { const s16x2_t sg = __builtin_bit_cast(s16x2_t, x) >> (short)15; return x ^ (__builtin_bit_cast(unsigned, sg) & 0x7fff7fffu); }
__device__ __forceinline__ float tk_value16(int k) { const int s = k >> 16; const int h = s ^ ((s >> 15) & 0x7fff); return (float)__builtin_bit_cast(_Float16, (unsigned short)(h & 0xffff)); }
__device__ __forceinline__ void phase7(ArgsP a, LAS unsigned char* lds, int tid, int lane, int wave) {
    unsigned char* ws = a->ws; const float* sA = (const float*)(ws + WS_R0); const float* sB = (const float*)(ws + WS_R4);
    int* idx = (int*)a->out; float* gates = a->out + (size_t)T_TOK * NPAIR;
    LAS float* tile = (LAS float*)(lds + wave * 8704); LAS unsigned* tileu = (LAS unsigned*)tile;
    const int gw = blockIdx.x * NWAVES + wave, NGW = gridDim.x * NWAVES;
    const int NGRP = (T_TOK * NHEAD) / 64;
#define P7_SRC(g_) ((const _Float16*)((((g_) * 64 / (T_TOK * 4)) != 0) ? sB : sA) + (size_t)((g_) * 64 % (T_TOK * 4)) * 256)
#define P7_LOAD(PRE, s_, c_) do { _Pragma("unroll") for (int it = 0; it < 8; ++it) PRE[it] = *(const u32x2*)((s_) + (size_t)(it * 8 + (lane >> 3)) * 256 + (c_) * 32 + (lane & 7) * 4); } while (0)
#define P7_H(x_, k_) ((k_) ? h16_hi(x_) : h16_lo(x_))
#define P7_STEP(PRE, c_) do { \
            _Pragma("unroll") for (int it = 0; it < 8; ++it) { LAS unsigned* d = tileu + (it * 8 + (lane >> 3)) * 17 + (lane & 7) * 2; d[0] = PRE[it].x; d[1] = PRE[it].y; }        \
            if ((c_) + 2 < 8) P7_LOAD(PRE, src, (c_) + 2); else if (has_next) P7_LOAD(PRE, nsrc, (c_) + 2 - 8); \
            asm volatile("s_waitcnt lgkmcnt(0)" ::: "memory"); \
            const int nb = 127 - ((c_) & 3) * 32; \
            _Pragma("unroll") for (int hb = 0; hb < 2; ++hb) { int bt[16]; \
                _Pragma("unroll") for (int j2 = 0; j2 < 8; ++j2) { const unsigned s_ = tk_sortable16x2(tileu[lane * 17 + hb * 8 + j2]); \
                    bt[2 * j2] = (int)((s_ << 16) | (unsigned)(nb - hb * 16 - 2 * j2)); bt[2 * j2 + 1] = (int)((s_ & 0xffff0000u) | (unsigned)(nb - hb * 16 - 2 * j2 - 1)); } \
                tk_sort16(bt); \
                if (hb == 0 && ((c_) & 3) == 0) { if ((c_) < 4) { _Pragma("unroll") for (int j = 0; j < 16; ++j) ka[j] = bt[j]; } else { _Pragma("unroll") for (int j = 0; j < 16; ++j) kb[j] = bt[j]; } }        \
                else if ((c_) < 4) tk_merge16(ka, bt); else tk_merge16(kb, bt); } \
            asm volatile("s_waitcnt lgkmcnt(0)" ::: "memory"); } while (0)
    if (gw >= NGRP) return;
    const _Float16* src = P7_SRC(gw);
    u32x2 preA[8], preB[8];
    P7_LOAD(preA, src, 0); P7_LOAD(preB, src, 1);
    for (int grp = gw; grp < NGRP; grp += NGW) {
        const int P0 = grp * 64, half = P0 / (T_TOK * 4), i0 = P0 % (T_TOK * 4);
        const bool has_next = grp + NGW < NGRP; const _Float16* nsrc = has_next ? P7_SRC(grp + NGW) : src;
        int ka[16], kb[16];
#pragma unroll
        for (int q = 0; q < 16; ++q) { ka[q] = (int)0x80000000; kb[q] = (int)0x80000000; }
        for (int c = 0; c < 8; c += 2) {
            P7_STEP(preA, c);
            P7_STEP(preB, c + 1);
        }
        src = nsrc;
        LAS unsigned char* tab = (LAS unsigned char*)tile + lane * 32;
#pragma unroll
        for (int q = 0; q < 16; ++q) { tab[q] = (unsigned char)(127 - (ka[q] & 127)); tab[16 + q] = (unsigned char)(127 - (kb[q] & 127)); }
        float va[16], vb[16];
#pragma unroll
        for (int q = 0; q < 16; ++q) { va[q] = tk_value16(ka[q]); vb[q] = tk_value16(kb[q]); }
        int kr[16];
#pragma unroll
        for (int q = 0; q < 16; ++q) kr[q] = (int)0x80000000;
        {
            int cand[64]; int nc = 0;
#pragma unroll
            for (int i = 0; i < 16; ++i)
#pragma unroll
                for (int j = 0; j < 16; ++j) if ((i + 1) * (j + 1) <= 16) { cand[nc] = (tk_sortable(va[i] + vb[j]) & ~255) | (255 - (i * 16 + j)); ++nc; }
#pragma unroll
            for (int q = 50; q < 64; ++q) cand[q] = (int)0x80000000;
#pragma unroll
            for (int bq = 0; bq < 4; ++bq) { int bt[16];
#pragma unroll
                for (int q = 0; q < 16; ++q) bt[q] = cand[bq * 16 + q];
                tk_sort16(bt); if (bq == 0) { _Pragma("unroll") for (int q = 0; q < 16; ++q) kr[q] = bt[q]; } else tk_merge16(kr, bt); } }
        asm volatile("s_waitcnt lgkmcnt(0)" ::: "memory");
        float ev[16]; int ex[16]; float sum = 0.f; const float v0 = tk_value(kr[0], 255);
#pragma unroll
        for (int q = 0; q < 16; ++q) { ev[q] = __expf(tk_value(kr[q], 255) - v0); sum += ev[q]; const int code = 255 - (kr[q] & 255); ex[q] = (int)tab[code >> 4] * 128 + (int)tab[16 + (code & 15)]; }
        const float inv = 1.0f / sum;
        const int i = i0 + lane, t = i >> 2, hh = half * 4 + (i & 3);
        int* ip = idx + (size_t)t * NPAIR + hh * 16; float* gp = gates + (size_t)t * NPAIR + hh * 16;
#pragma unroll
        for (int q = 0; q < 4; ++q) { *(int4*)(ip + 4 * q) = make_int4(ex[4 * q], ex[4 * q + 1], ex[4 * q + 2], ex[4 * q + 3]);
            *(f32x4*)(gp + 4 * q) = (f32x4){ev[4 * q] * inv, ev[4 * q + 1] * inv, ev[4 * q + 2] * inv, ev[4 * q + 3] * inv}; }
        asm volatile("s_waitcnt lgkmcnt(0)" ::: "memory");
    }
#undef P7_SRC
#undef P7_H
#undef P7_LOAD
#undef P7_STEP
}

__device__ __forceinline__ float fdot2bf(unsigned a, unsigned b, float c) { return __builtin_amdgcn_fdot2_f32_bf16(__builtin_bit_cast(bf16x2_t, a), __builtin_bit_cast(bf16x2_t, b), c, false); }
__device__ __forceinline__ float dot8bf(const u32x4 h, const u32x4 w) { return fdot2bf(h.w, w.w, fdot2bf(h.z, w.z, fdot2bf(h.y, w.y, fdot2bf(h.x, w.x, 0.f)))); }
template <int M> __device__ __forceinline__ float xshf(float v) {
    if (M == 1) return __int_as_float(__builtin_amdgcn_mov_dpp(__float_as_int(v), 0xB1, 0xF, 0xF, true));
    if (M == 2) return __int_as_float(__builtin_amdgcn_mov_dpp(__float_as_int(v), 0x4E, 0xF, 0xF, true));
    return __int_as_float(__builtin_amdgcn_ds_swizzle(__float_as_int(v), (M << 10) | 0x1F));
}
__device__ __forceinline__ float tred16(float (&v)[16], int sub) {
#pragma unroll
    for (int k = 0; k < 8; ++k) { const float s = (sub & 8) ? v[k] : v[k + 8], kp = (sub & 8) ? v[k + 8] : v[k]; v[k] = kp + xshf<8>(s); }
#pragma unroll
    for (int k = 0; k < 4; ++k) { const float s = (sub & 4) ? v[k] : v[k + 4], kp = (sub & 4) ? v[k + 4] : v[k]; v[k] = kp + xshf<4>(s); }
#pragma unroll
    for (int k = 0; k < 2; ++k) { const float s = (sub & 2) ? v[k] : v[k + 2], kp = (sub & 2) ? v[k + 2] : v[k]; v[k] = kp + xshf<2>(s); }
    { const float s = (sub & 1) ? v[0] : v[1], kp = (sub & 1) ? v[1] : v[0]; v[0] = kp + xshf<1>(s); }
    return v[0];
}
template <int M4, int M2, int M1> __device__ __forceinline__ void tred8x16(float (&v)[16], int lane) {
#pragma unroll
    for (int k = 0; k < 8; ++k) { const float s = (lane & M4) ? v[k] : v[k + 8], kp = (lane & M4) ? v[k + 8] : v[k]; v[k] = kp + (M4 == 32 ? __shfl_xor(s, 32) : xshf<(M4 & 31)>(s)); }
#pragma unroll
    for (int k = 0; k < 4; ++k) { const float s = (lane & M2) ? v[k] : v[k + 4], kp = (lane & M2) ? v[k + 4] : v[k]; v[k] = kp + (M2 == 32 ? __shfl_xor(s, 32) : xshf<(M2 & 31)>(s)); }
#pragma unroll
    for (int k = 0; k < 2; ++k) { const float s = (lane & M1) ? v[k] : v[k + 2], kp = (lane & M1) ? v[k + 2] : v[k]; v[k] = kp + (M1 == 32 ? __shfl_xor(s, 32) : xshf<(M1 & 31)>(s)); }
}
__device__ __forceinline__ void phase8(ArgsP a, LAS unsigned char* lds, int lane, int wave) {
    unsigned char* ws = a->ws; const unsigned char* h8 = ws + WS_H8; const unsigned char* PU = ws + WS_PU; float* part = (float*)(ws + WS_R0);
    const int* idx = (const int*)a->out;
    const int sub = lane & 7, grp = lane >> 3, tp = (lane & 7) * 16 + (lane >> 3);
    LAS int* ib = (LAS int*)(lds + wave * 1536);
#define P8_IDS(E, buf) do { _Pragma("unroll") for (int q_ = 0; q_ < 4; ++q_) { const i32x4 v_ = *(const LAS i32x4*)((buf) + grp * 16 + 4 * q_); E[4 * q_] = v_.x; E[4 * q_ + 1] = v_.y; E[4 * q_ + 2] = v_.z; E[4 * q_ + 3] = v_.w; } } while (0)
#define P8_GATHER(U, E) do { _Pragma("unroll") for (int j_ = 0; j_ < 16; ++j_) U[j_] = *(const u32x4*)(PUx + (size_t)E[j_] * 128); } while (0)
#define P8_DOT(D, U) do { _Pragma("unroll") for (int j_ = 0; j_ < 16; ++j_) D[j_] = (float)__builtin_amdgcn_sdot4((int)U[j_].w, (int)h8_.w, __builtin_amdgcn_sdot4((int)U[j_].z, (int)h8_.z, __builtin_amdgcn_sdot4((int)U[j_].y, (int)h8_.y, __builtin_amdgcn_sdot4((int)U[j_].x, (int)h8_.x, 0, false), false), false), false); } while (0)
#define P8_TOKEN(U, t_) do { const u32x4 h8_ = *(const u32x4*)(h8 + ((size_t)x * T_TOK + (t_)) * 128 + sub * 16); \
        float d[16]; P8_DOT(d, U); tred8x16<4, 2, 1>(d, lane); \
        float* pp_ = part + ((size_t)x * T_TOK + (t_)) * NPAIR + 16 * sub + grp; pp_[0] = d[0] * (1.0f / (PEER_U_SCALE * PEER_H_SCALE)); pp_[8] = d[1] * (1.0f / (PEER_U_SCALE * PEER_H_SCALE)); } while (0)
    LAS int* ibs[3] = {ib, ib + 128, ib + 256};
    for (int cell = blockIdx.x; cell < 256; cell += gridDim.x) {
        const int x = cell & 7, c = cell >> 3; const unsigned char* PUx = PU + (size_t)x * (16384 * 128) + sub * 16; const int tend = c * 1024 + 1024;
        int t = c * 1024 + wave;
        u32x4 uA[16], uB[16], uC[16]; int e[16]; int i0, i1;
#define P8_LDIDX(t_) do { const int tt_ = (t_) < tend ? (t_) : tend - 8; i0 = idx[(size_t)tt_ * NPAIR + lane]; i1 = idx[(size_t)tt_ * NPAIR + 64 + lane]; } while (0)
#define P8_PUT(buf) do { (buf)[tp] = i0; (buf)[tp + 8] = i1; } while (0)
        P8_LDIDX(t); P8_PUT(ibs[0]); P8_LDIDX(t + 8); P8_PUT(ibs[1]); P8_LDIDX(t + 16);
        P8_IDS(e, ibs[0]); P8_GATHER(uA, e); P8_IDS(e, ibs[1]); P8_GATHER(uB, e);
        for (int n = 0; n < 126; n += 3, t += 24) {
            P8_PUT(ibs[2]); P8_LDIDX(t + 24); P8_IDS(e, ibs[2]); P8_GATHER(uC, e); P8_TOKEN(uA, t);
            P8_PUT(ibs[0]); P8_LDIDX(t + 32); P8_IDS(e, ibs[0]); P8_GATHER(uA, e); P8_TOKEN(uB, t + 8);
            P8_PUT(ibs[1]); P8_LDIDX(t + 40); P8_IDS(e, ibs[1]); P8_GATHER(uB, e); P8_TOKEN(uC, t + 16);
        }
        P8_TOKEN(uA, t); P8_TOKEN(uB, t + 8);
#undef P8_LDIDX
#undef P8_PUT
    }
#undef P8_IDS
#undef P8_GATHER
#undef P8_DOT
#undef P8_TOKEN
}
__device__ __forceinline__ void phase9w(ArgsP a, int tid) {
    const float* part = (const float*)(a->ws + WS_R0); const float* gates = a->out + (size_t)T_TOK * NPAIR; float* wout = (float*)(a->ws + WS_W);
    const size_t n4 = (size_t)T_TOK * NPAIR / 4;
    for (size_t i = (size_t)blockIdx.x * NTHR + tid; i < n4; i += (size_t)gridDim.x * NTHR) {
        f32x4 h = *((const f32x4*)part + i);
#pragma unroll
        for (int xx = 1; xx < 8; ++xx) h += *((const f32x4*)(part + (size_t)xx * T_TOK * NPAIR) + i);
        const f32x4 g = *((const f32x4*)gates + i);
        *((f32x4*)wout + i) = (f32x4){g[0] * gelu_erf(h[0]), g[1] * gelu_erf(h[1]), g[2] * gelu_erf(h[2]), g[3] * gelu_erf(h[3])};
    }
}
__device__ __forceinline__ void phase9(ArgsP a, LAS unsigned char* lds, int lane, int wave) {
    unsigned char* ws = a->ws; const unsigned char* PV = ws + WS_PV; bf16_t* f = (bf16_t*)(ws + WS_R4);
    const int* idx = (const int*)a->out; const float* wgt = (const float*)(ws + WS_W);
    const int sub = lane & 7, grp = lane >> 3, tp = (lane & 7) * 16 + (lane >> 3);
    LAS u32x2* eb = (LAS u32x2*)(lds + wave * 2048);
#define P9_LD(t_, W0, W1, I0, I1) do { W0 = wgt[(size_t)(t_) * NPAIR + lane]; W1 = wgt[(size_t)(t_) * NPAIR + 64 + lane]; I0 = idx[(size_t)(t_) * NPAIR + lane]; I1 = idx[(size_t)(t_) * NPAIR + 64 + lane]; } while (0)
#define P9_EW(E, W, buf) do { _Pragma("unroll") for (int q_ = 0; q_ < 8; ++q_) { const u32x4 v_ = *(const LAS u32x4*)((buf) + grp * 16 + 2 * q_); E[2 * q_] = (int)v_.x; W[2 * q_] = __uint_as_float(v_.y); E[2 * q_ + 1] = (int)v_.z; W[2 * q_ + 1] = __uint_as_float(v_.w); } } while (0)
#define P9_GATHER(U, E) do { _Pragma("unroll") for (int j_ = 0; j_ < 16; ++j_) U[j_] = *(const u32x4*)(PVx + (size_t)E[j_] * 128); } while (0)
#define P9_TOKEN(U, W, t_) do { f32x2 acc[8] = {{0.f, 0.f}, {0.f, 0.f}, {0.f, 0.f}, {0.f, 0.f}, {0.f, 0.f}, {0.f, 0.f}, {0.f, 0.f}, {0.f, 0.f}}; \
        _Pragma("unroll") for (int j_ = 0; j_ < 16; ++j_) { const f32x2 w2_ = {W[j_], W[j_]}; \
            acc[0] += w2_ * __builtin_amdgcn_cvt_pk_f32_fp8((int)U[j_].x, false); acc[1] += w2_ * __builtin_amdgcn_cvt_pk_f32_fp8((int)U[j_].x, true); acc[2] += w2_ * __builtin_amdgcn_cvt_pk_f32_fp8((int)U[j_].y, false); acc[3] += w2_ * __builtin_amdgcn_cvt_pk_f32_fp8((int)U[j_].y, true); \
            acc[4] += w2_ * __builtin_amdgcn_cvt_pk_f32_fp8((int)U[j_].z, false); acc[5] += w2_ * __builtin_amdgcn_cvt_pk_f32_fp8((int)U[j_].z, true); acc[6] += w2_ * __builtin_amdgcn_cvt_pk_f32_fp8((int)U[j_].w, false); acc[7] += w2_ * __builtin_amdgcn_cvt_pk_f32_fp8((int)U[j_].w, true); } \
        float v_[16]; _Pragma("unroll") for (int k_ = 0; k_ < 8; ++k_) { v_[2 * k_] = acc[k_].x; v_[2 * k_ + 1] = acc[k_].y; } \
        tred8x16<8, 16, 32>(v_, lane);            \
        const int r_ = ((lane >> 3) & 1) * 4 + ((lane >> 4) & 1) * 2 + (lane >> 5); \
        *(unsigned*)(f + (size_t)(t_) * 1024 + x * 128 + sub * 16 + 2 * r_) = pkbf(v_[0] * (1.0f / PEER_V_SCALE), v_[1] * (1.0f / PEER_V_SCALE)); } while (0)
    for (int cell = blockIdx.x; cell < 256; cell += gridDim.x) {
        const int x = cell & 7, c = cell >> 3; const unsigned char* PVx = PV + (size_t)x * (16384 * 128) + sub * 16; const int tend = c * 1024 + 1024;
        int t = c * 1024 + wave;
        float w0, w1; int i0, i1;
        P9_LD(t, w0, w1, i0, i1);
        eb[tp] = (u32x2){(unsigned)i0, __float_as_uint(w0)}; eb[tp + 8] = (u32x2){(unsigned)i1, __float_as_uint(w1)};
        P9_LD(t + 8, w0, w1, i0, i1);
        u32x4 uA[16], uB[16]; int e[16]; float wA[16], wB[16];
        P9_EW(e, wA, eb); P9_GATHER(uA, e);
        for (int n = 0; n < 128; n += 2, t += 16) {
            LAS u32x2* b1 = eb + 128;
            b1[tp] = (u32x2){(unsigned)i0, __float_as_uint(w0)}; b1[tp + 8] = (u32x2){(unsigned)i1, __float_as_uint(w1)};
            { const int tn = t + 16 < tend ? t + 16 : t; P9_LD(tn, w0, w1, i0, i1); }
            P9_EW(e, wB, b1); P9_GATHER(uB, e);
            P9_TOKEN(uA, wA, t);
            eb[tp] = (u32x2){(unsigned)i0, __float_as_uint(w0)}; eb[tp + 8] = (u32x2){(unsigned)i1, __float_as_uint(w1)};
            { const int tn = t + 24 < tend ? t + 24 : t; P9_LD(tn, w0, w1, i0, i1); }
            if (n + 2 < 128) { P9_EW(e, wA, eb); P9_GATHER(uA, e); }
            P9_TOKEN(uB, wB, t + 8);
        }
    }
#undef P9_LD
#undef P9_EW
#undef P9_GATHER
#undef P9_TOKEN
}

constexpr int N_PHASES = 13;
__global__ void __launch_bounds__(NTHR, 2) mk_fwd(Args a_by_value) {
    extern __shared__ __attribute__((aligned(16))) unsigned char lds_raw[];
    LAS unsigned char* lds = (LAS unsigned char*)lds_raw;
    const int tid = threadIdx.x, lane = tid & 63, wave = __builtin_amdgcn_readfirstlane(tid >> 6);
    int lo, hi; { ArgsP a0 = args_ptr(); lo = a0->ph_lo; hi = a0->ph_hi; }
    const int G = gridDim.x;
#ifndef PHMASK
#define PHMASK 0xFFFF
#endif
#define IN(k) (((PHMASK >> (k)) & 1) && lo <= (k) && (k) < hi)
#if defined(MK_CGSYNC)
#define SEAM(k) do { if (IN(k) && IN((k) + 1)) { cg::this_grid().sync(); } } while (0)
#else
    if (tid == 0) { ((LAS unsigned*)(lds + LDS_BAR_OFF))[0] = 0u; ((LAS unsigned*)(lds + LDS_BAR_OFF))[1] = 0u; }
    __syncthreads();
    XcdBarrier xbar; { ArgsP a0 = args_ptr(); xbar = xcd_barrier_post((unsigned*)(a0->ws + WS_BAR) + a0->li * XCD_BAR_WORDS, (volatile LAS unsigned*)(lds + LDS_BAR_OFF)); }
    if (lo < 0) cg::this_grid().sync();
#define SEAM(k) do { if (IN(k) && IN((k) + 1)) { xcd_barrier(xbar); } } while (0)
#endif
    if (IN(0)) { ArgsP a = args_ptr(); phase0(a, lds, tid, lane, wave); }
    SEAM(0);
    if (IN(1)) {
        ArgsP a = args_ptr(); unsigned char* ws = a->ws;
        int k1 = DM; asm volatile("" : "+s"(k1));
        pg8::Gemm g{(const bf16_t*)(ws + WS_R0), (const bf16_t*)(ws + WS_WIN_T), T_TOK, NZ, k1, nullptr, nullptr}; pg8::StaticOrder S; S.init(T_TOK, NZ, G, (int)blockIdx.x);
        static_assert(WS_R2 - WS_R1 == (size_t)T_TOK * 2048 && WS_R3 - WS_R2 == WS_R2 - WS_R1 && WS_R4 - WS_R3 == WS_R2 - WS_R1 && WS_R5 - WS_R4 == WS_R2 - WS_R1, "R1..R5 are consecutive [T][1024] bf16 tensors");
        EpiZ E{(bf16_t*)(ws + WS_R1), (bf16_t*)a->out, a->in[3], 1.0f / WIN_SCALE};
        const int cls = (int)((blockIdx.x >> 3) & 7);
        phase0_deferred(a, lds, tid, lane, wave, 0, cls);
        pg8::gemm_phase<EpiZ, pg8::StaticOrder, PG8_AL1, PG8_S2, true>(lds, g, S, E);
        phase0_deferred(a, lds, tid, lane, wave, 1, cls);
    }
#if defined(MK_DUPX) && MK_DUPX == 11
    if (IN(1)) {
        ArgsP a = args_ptr(); unsigned char* ws = a->ws; __syncthreads();
        int k1 = DM; asm volatile("" : "+s"(k1));
        pg8::Gemm g{(const bf16_t*)(ws + WS_R0), (const bf16_t*)(ws + WS_WIN_T), T_TOK, NZ, k1, nullptr, nullptr}; pg8::StaticOrder S; S.init(T_TOK, NZ, G, (int)blockIdx.x);
        EpiZ E{(bf16_t*)(ws + WS_R1), (bf16_t*)a->out, a->in[3], 1.0f / WIN_SCALE};
        pg8::gemm_phase<EpiZ, pg8::StaticOrder, PG8_AL1, PG8_S2, true>(lds, g, S, E);
    }
#endif
#if defined(MK_DUPX) && MK_DUPX == 1
    if (IN(1)) {
        ArgsP a = args_ptr(); unsigned char* ws = a->ws; __syncthreads();
        int kprobe = MK_PROBEK; asm volatile("" : "+s"(kprobe));
        pg8::Gemm g{(const bf16_t*)(ws + WS_R0), (const bf16_t*)(ws + WS_WIN_T), T_TOK, NZ, kprobe, nullptr, nullptr}; pg8::StaticOrder S; S.init(T_TOK, NZ, G, (int)blockIdx.x);
        EpiNull E{(float*)(ws + WS_END)};
        pg8::gemm_phase<EpiNull, pg8::StaticOrder, PG8_AL1, PG8_S2, true>(lds, g, S, E);
    }
#endif
    SEAM(1);
    const bool p2_first = ((blockIdx.x >> 3) & 1) == 0;
    if (IN(2) && (p2_first || !IN(3))) { ArgsP a = args_ptr(); phase2(a, lds, tid, lane, wave); }
#if defined(MK_DUPX) && MK_DUPX == 2
    if (IN(2)) { ArgsP a = args_ptr(); phase2(a, lds, tid, lane, wave, true); }
#endif
#if defined(MK_NAIVE_ATTN)
    SEAM(2);
    if (IN(3)) { ArgsP a = args_ptr(); phase3_naive(a, lds, tid, lane, wave); }
#else
    if (IN(3)) { ArgsP a = args_ptr(); phase3_fast(a, lds, tid, lane, wave); }
    if (IN(2) && IN(3) && !p2_first) { __syncthreads(); ArgsP a = args_ptr(); phase2(a, lds, tid, lane, wave); }
#if defined(MK_DUPX) && MK_DUPX == 3
    if (IN(3)) { __syncthreads(); ArgsP a = args_ptr(); phase3_fast<MK_ATTVAR>(a, lds, tid, lane, wave, true); }
#endif
#endif
    SEAM(3);
    if (IN(4)) {
        ArgsP a = args_ptr(); unsigned char* ws = a->ws;
        pg8::Gemm g{(const bf16_t*)(ws + WS_R1), (const bf16_t*)(ws + WS_PA_T), T_TOK, DM, DM, (const bf16_t*)(ws + WS_R3), (const bf16_t*)(ws + WS_PB_T)}; pg8::DualOrder S; S.init(T_TOK, DM, G, (int)blockIdx.x);
        EpiGate E{(bf16_t*)(ws + WS_R2), (const unsigned char*)a->out, (const unsigned char*)a->out + (size_t)T_TOK * 1024};
        pg8::gemm_phase<EpiGate, pg8::DualOrder, PG8_AL, PG8_S2>(lds, g, S, E);
    }
    SEAM(4);
    if (IN(5)) {
        ArgsP a = args_ptr(); unsigned char* ws = a->ws;
        pg8::Gemm g{(const bf16_t*)(ws + WS_R2), (const bf16_t*)(ws + WS_WOUT_T), T_TOK, DM, DM, nullptr, nullptr}; pg8::StaticOrder S; S.init(T_TOK, DM, G, (int)blockIdx.x);
        EpiRes E{a->in[0], (bf16_t*)(ws + WS_R0)};
        pg8::gemm_phase<EpiRes, pg8::StaticOrder, PG8_AL, PG8_S2>(lds, g, S, E);
    }
    SEAM(5);
    if (IN(6)) {
        ArgsP a = args_ptr(); unsigned char* ws = a->ws;
        const bool ln_first = ((blockIdx.x >> 3) & 1) == 0;
        if (ln_first) { phase5b(a, lane, wave); __syncthreads(); }
        int kpl = 256; asm volatile("" : "+s"(kpl));
        pg8::Gemm g{(const bf16_t*)(ws + WS_PB16), (const bf16_t*)(ws + WS_WPLE_T), T_TOK, DM, kpl, nullptr, nullptr}; pg8::StaticOrder S; S.init(T_TOK, DM, G, (int)blockIdx.x);
        EpiMix<0> E{(bf16_t*)(ws + WS_R2), nullptr, nullptr};
        pg8::gemm_phase<EpiMix<0>, pg8::StaticOrder, PG8_AL, PG8_S2>(lds, g, S, E);
        if (!ln_first) { __syncthreads(); phase5b(a, lane, wave); }
    }
    SEAM(6);
    if (IN(7)) {
        ArgsP a = args_ptr(); unsigned char* ws = a->ws;
        pg8::Gemm g{(const bf16_t*)(ws + WS_R3), (const bf16_t*)(ws + WS_WQ2_T), T_TOK, 3072, DM, nullptr, nullptr}; pg8::StaticOrder S; S.init(T_TOK, 3072, G, (int)blockIdx.x);
        EpiP6 E{(float*)(ws + WS_R0), (float*)(ws + WS_R4), (bf16_t*)(ws + WS_R2), a->in[20]};
        pg8::gemm_phase<EpiP6, pg8::StaticOrder, PG8_AL, PG8_S2>(lds, g, S, E);
    }
    SEAM(7);
    if (IN(8)) { ArgsP a = args_ptr(); phase7(a, lds, tid, lane, wave); }
#if defined(MK_DUPX) && MK_DUPX == 8
    if (IN(8)) { __syncthreads(); ArgsP a = args_ptr(); phase7(a, lds, tid, lane, wave); }
#endif
    SEAM(8);
    if (IN(9)) { ArgsP a = args_ptr(); phase8(a, lds, lane, wave); }
    SEAM(9);
    if (IN(10)) { { ArgsP a = args_ptr(); phase9w(a, tid); }
#if defined(MK_CGSYNC)
        cg::this_grid().sync();
#else
        xcd_barrier(xbar);
#endif
        { ArgsP a = args_ptr(); phase9(a, lds, lane, wave); } }
    SEAM(10);
    if (IN(11)) { ArgsP a = args_ptr(); phase10(a, lane, wave); }
#undef IN
#undef SEAM
}


extern "C" void kernel_launch(void* const* d_in, const int* in_sizes, int n_in, void* d_out, int out_size, void* d_ws, size_t ws_size, hipStream_t stream) {
    static int grid = 0;
    if (grid == 0) {
        if (n_in != 23 || in_sizes[0] != T_TOK * DM || out_size != T_TOK * DM || ws_size < 512 * MiB) { fprintf(stderr, "kernel_launch: unexpected shapes (n_in %d, in0 %d, out %d, ws %zu)\n", n_in, n_in > 0 ? in_sizes[0] : -1, out_size, ws_size); grid = -1; return; }
        int dev = 0, cus = 0, per_cu = 0;
        (void)hipGetDevice(&dev); (void)hipDeviceGetAttribute(&cus, hipDeviceAttributeMultiprocessorCount, dev);
        if (hipFuncSetAttribute((const void*)mk_fwd, hipFuncAttributeMaxDynamicSharedMemorySize, LDS_BYTES) != hipSuccess) { fprintf(stderr, "kernel_launch: hipFuncSetAttribute failed\n"); grid = -1; return; }
        if (hipOccupancyMaxActiveBlocksPerMultiprocessor(&per_cu, (const void*)mk_fwd, NTHR, LDS_BYTES) != hipSuccess || per_cu < 1) { fprintf(stderr, "kernel_launch: occupancy query failed (%d)\n", per_cu); grid = -1; return; }
        grid = cus * 1;
    }
    if (grid < 0) return;
    Args a{};
    for (int i = 0; i < 23; ++i) a.in[i] = (const float*)d_in[i];
    a.out = (float*)d_out; a.ws = (unsigned char*)d_ws;
    (void)hipMemsetAsync((unsigned char*)d_ws + WS_BAR, 0, WS_BAR_BYTES, stream);
    int launch_no = 0;
#if defined(MK_DUP)
    {   void* args[] = {&a};
        a.ph_lo = 0; a.ph_hi = MK_DUP + 1; a.li = launch_no++; (void)hipLaunchCooperativeKernel((const void*)mk_fwd, dim3(grid), dim3(NTHR), args, LDS_BYTES, stream);
        a.ph_lo = MK_DUP; a.ph_hi = 12; a.li = launch_no++; (void)hipLaunchCooperativeKernel((const void*)mk_fwd, dim3(grid), dim3(NTHR), args, LDS_BYTES, stream);
    }
#else
    a.ph_lo = 0; a.ph_hi = 12;
    void* args[] = {&a};
    hipError_t e = hipLaunchCooperativeKernel((const void*)mk_fwd, dim3(grid), dim3(NTHR), args, LDS_BYTES, stream);
    if (e != hipSuccess) fprintf(stderr, "kernel_launch: cooperative launch failed: %s (grid %d)\n", hipGetErrorString(e), grid);
#endif
}
```

```cpp
#define MK_CLS 0
#include <hip/hip_runtime.h>
#include <hip/hip_cooperative_groups.h>
#include <cstdio>
#include <cstdint>
#ifndef PG8_AL
#define PG8_AL true
#endif
#ifndef PG8_AL1
#define PG8_AL1 PG8_AL
#endif
#ifndef PG8_S2
#define PG8_S2 true
#endif
namespace pg8 {
#define PG8_LAS __attribute__((address_space(3)))
typedef unsigned short bf16_t;
typedef short bf16x8 __attribute__((ext_vector_type(8)));
typedef float f32x4 __attribute__((ext_vector_type(4)));
typedef unsigned u32x4 __attribute__((ext_vector_type(4)));
constexpr int BM = 256, BK = 64, HALF = 128, HTB = HALF * BK * 2  , STAGE_BYTES = 8 * HTB, NXCD = 8, WGM = 8;

__host__ __device__ __forceinline__ int lds_byte(int r, int c) { const int st = (r >> 4) * 2 + (c >> 5), rr = r & 15, cc = c & 31, ob = rr * 64 + cc * 2; return st * 1024 + (ob ^ (((ob >> 9) & 1) << 5)); }
__host__ __device__ __forceinline__ void stage_rc(int b, int& R, int& C) { const int st = b / 1024, sb = b % 1024, swz = sb ^ (((sb >> 9) & 1) << 5); R = (st >> 1) * 16 + swz / 64; C = (st & 1) * 32 + (swz % 64) / 2; }
__host__ __device__ __forceinline__ int perm32(int rho) { const int n = rho >> 4, i = rho & 15; return 8 * (i >> 2) + 4 * n + (i & 3); }

struct Unit { int pm, pn, half; };
struct Gemm { const bf16_t* A; const bf16_t* Bt; int M, N, K; const bf16_t* A2; const bf16_t* Bt2; };

struct StaticOrder {
    int nM, nN, nwg, G, c;
    __host__ __device__ void init(int M, int N, int G_, int c_) { nM = M / BM; nN = N / BM; nwg = nM * nN; G = G_; c = c_; }
    __host__ __device__ bool next(int i, Unit& u) const {
        const long L = (long)i * G + c; if (L >= nwg) return false;
        int wgid = (int)L; { const int q = nwg / NXCD, r = nwg % NXCD, xcd = wgid % NXCD, off = wgid / NXCD; wgid = (xcd < r ? xcd * (q + 1) : r * (q + 1) + (xcd - r) * q) + off; }
        const int nig = WGM * nN, gid = wgid / nig, fm = gid * WGM, gsz = (nM - fm) < WGM ? (nM - fm) : WGM;
        u.pm = fm + ((wgid % nig) % gsz); u.pn = (wgid % nig) / gsz; u.half = 0; return true;
    }
    __device__ __forceinline__ void a_ready(const Unit&) const {}
    __device__ __forceinline__ void done(const Unit&) const {}
};
struct DualOrder : StaticOrder {
    __host__ __device__ bool next(int i, Unit& u) const { if (!StaticOrder::next(i >> 1, u)) return false; u.half = i & 1; return true; }
};
__device__ __forceinline__ unsigned cvt_pk_bf16(float lo, float hi) { unsigned r; asm volatile("v_cvt_pk_bf16_f32 %0, %1, %2" : "=v"(r) : "v"(lo), "v"(hi)); return r; }
typedef float f32x2 __attribute__((ext_vector_type(2)));
__device__ __forceinline__ f32x2 gelu_pk(f32x2 v) {
    const f32x2 av = __builtin_elementwise_abs(v), d = av * 0.2316418882f + 1.0f;
    f32x2 t; t.x = __builtin_amdgcn_rcpf(d.x); t.y = __builtin_amdgcn_rcpf(d.y);
    f32x2 q = t * 0.5307027145f + (-0.7265760135f); q = q * t + 0.7107068705f; q = q * t + (-0.142248368f); q = q * t + 0.127414796f; q = q * t;
    const f32x2 s = (v * v) * (-0.72134752044f);
    f32x2 e; e.x = __builtin_amdgcn_exp2f(s.x); e.y = __builtin_amdgcn_exp2f(s.y);
    const f32x2 m = v * (q * e), r = v - m;
    f32x2 o; o.x = v.x < 0.f ? m.x : r.x; o.y = v.y < 0.f ? m.y : r.y; return o;
}
typedef int i32x8_t __attribute__((ext_vector_type(8)));
__device__ __forceinline__ i32x8_t cat8(bf16x8 lo, bf16x8 hi) { typedef int i32x4_t __attribute__((ext_vector_type(4))); const i32x4_t a = __builtin_bit_cast(i32x4_t, lo), b = __builtin_bit_cast(i32x4_t, hi); return __builtin_shufflevector(a, b, 0, 1, 2, 3, 4, 5, 6, 7); }
template <class Epi, class Sched, bool ALIGN_EPI = false, bool SP2 = false, bool F8 = false>
__device__ __forceinline__ void gemm_phase(PG8_LAS unsigned char* lds, const Gemm g, const Sched& S, const Epi& E) {
    const int tid = threadIdx.x, wid = __builtin_amdgcn_readfirstlane(tid >> 6), lane = tid & 63, wr = wid >> 2, wc = wid & 3, fr = lane & 15, fq = lane >> 4;
    const int K = g.K, Kb = F8 ? K : 2 * K  , nt = Kb / (2 * BK);
    unsigned voffA[2], voffB[2];
#pragma unroll
    for (int i = 0; i < 2; ++i) { int R, C; stage_rc(tid * 16 + i * 8192, R, C); const int Rb = Epi::PERM ? (64 * (R >> 5) + perm32(R & 31)) : R;
        voffA[i] = (unsigned)(R * Kb + C * 2); voffB[i] = (unsigned)(Rb * Kb + C * 2); }
    const size_t kstep = (size_t)(BK * 2);
    const size_t hstep = (size_t)HALF * Kb;
    const size_t hstepB = Epi::PERM ? (size_t)32 * Kb : hstep;
    const size_t tstep = 2 * hstep;
    const unsigned ldsw = (unsigned)wid * 1024u;
    const int aoff = lds_byte(wr * 64 + fr, fq * 8), boff = lds_byte(wc * 32 + fr, fq * 8);
#define PG8_SA(b, h) (((b) * 2 + (h)) * HTB)
#define PG8_SB(b, h) ((4 + (b) * 2 + (h)) * HTB)
#ifndef PG8_AUX_A
#define PG8_AUX_A 0
#endif
#ifndef PG8_AUX_B
#define PG8_AUX_B 0
#endif
#define PG8_STAGE(bufoff, gbase, voff) do { _Pragma("unroll") for (int _i = 0; _i < 2; ++_i) { \
        if ((bufoff) < 4 * HTB) __builtin_amdgcn_global_load_lds((const unsigned*)((const char*)(gbase) + (voff)[_i]), (PG8_LAS unsigned*)(lds + (bufoff) + ldsw + _i * 8192), 16, 0, PG8_AUX_A); \
        else __builtin_amdgcn_global_load_lds((const unsigned*)((const char*)(gbase) + (voff)[_i]), (PG8_LAS unsigned*)(lds + (bufoff) + ldsw + _i * 8192), 16, 0, PG8_AUX_B); } } while (0)
#define PG8_LDA(dst, b, h) do { _Pragma("unroll") for (int m = 0; m < 4; ++m) _Pragma("unroll") for (int k = 0; k < 2; ++k) dst[m][k] = *(const PG8_LAS bf16x8*)(lds + PG8_SA(b, h) + aoff + m * 2048 + k * 1024); } while (0)
#define PG8_LDB(dst, b, h) do { _Pragma("unroll") for (int n = 0; n < 2; ++n) _Pragma("unroll") for (int k = 0; k < 2; ++k) dst[n][k] = *(const PG8_LAS bf16x8*)(lds + PG8_SB(b, h) + boff + n * 2048 + k * 1024); } while (0)
#define PG8_MMA_BF(ai, bj, At, Bt) do { _Pragma("unroll") for (int m = 0; m < 4; ++m) _Pragma("unroll") for (int n = 0; n < 2; ++n) _Pragma("unroll") for (int k = 0; k < 2; ++k) \
        acc[ai][bj][m][n] = __builtin_amdgcn_mfma_f32_16x16x32_bf16(Bt[n][k], At[m][k], acc[ai][bj][m][n], 0, 0, 0); } while (0)
#define PG8_MMA_F8(ai, bj, At, Bt) do { _Pragma("unroll") for (int m = 0; m < 4; ++m) _Pragma("unroll") for (int n = 0; n < 2; ++n) \
        asm volatile("v_mfma_scale_f32_16x16x128_f8f6f4 %0, %1, %2, %0, %3, %3 op_sel_hi:[0,0,0]" : "+v"(acc[ai][bj][m][n]) : "v"(*(const i32x8_t*)&Bt[n][0]), "v"(*(const i32x8_t*)&At[m][0]), "v"(0x7f7f7f7f)); } while (0)
#define PG8_MMA(ai, bj, At, Bt) do { __builtin_amdgcn_s_setprio(1); if constexpr (F8) { PG8_MMA_F8(ai, bj, At, Bt); } else { PG8_MMA_BF(ai, bj, At, Bt); } __builtin_amdgcn_s_setprio(0); } while (0)
#define PG8_WAIT_V(n) asm volatile("s_waitcnt vmcnt(" #n ")" ::: "memory")
#define PG8_WAIT_L(n) asm volatile("s_waitcnt lgkmcnt(" #n ")" ::: "memory")
#define PG8_BAR __builtin_amdgcn_s_barrier()
#define PG8_SCHED __builtin_amdgcn_sched_barrier(0)
    Unit cur, nxt; int ui = 0;
    if (!S.next(0, cur)) return;
    f32x4 acc[2][2][4][2];
#pragma unroll
    for (int a = 0; a < 2; ++a)
#pragma unroll
        for (int b = 0; b < 2; ++b)
#pragma unroll
            for (int m = 0; m < 4; ++m)
#pragma unroll
                for (int n = 0; n < 2; ++n) acc[a][b][m][n] = (f32x4){0.f, 0.f, 0.f, 0.f};
    bf16x8 At[4][2], B0[2][2], B1[2][2];
    const char* cA = (const char*)(cur.half ? g.A2 : g.A) + (size_t)cur.pm * tstep; const char* cB = (const char*)(cur.half ? g.Bt2 : g.Bt) + (size_t)cur.pn * tstep;
    S.a_ready(cur);
    if constexpr (SP2) {
        PG8_STAGE(PG8_SB(0, 0), cB, voffB); PG8_STAGE(PG8_SB(0, 1), cB + hstepB, voffB); PG8_STAGE(PG8_SA(0, 0), cA, voffA); PG8_STAGE(PG8_SA(0, 1), cA + hstep, voffA);
        if (wr == 1) PG8_BAR;
        PG8_WAIT_V(2); PG8_BAR;
        PG8_STAGE(PG8_SB(1, 0), cB + kstep, voffB); PG8_STAGE(PG8_SA(1, 0), cA + kstep, voffA); PG8_STAGE(PG8_SB(1, 1), cB + hstepB + kstep, voffB);
        PG8_WAIT_V(6); PG8_BAR;
    } else {
        PG8_STAGE(PG8_SB(0, 0), cB, voffB); PG8_STAGE(PG8_SA(0, 0), cA, voffA); PG8_STAGE(PG8_SB(0, 1), cB + hstepB, voffB); PG8_STAGE(PG8_SA(0, 1), cA + hstep, voffA);
        if (wr == 1) PG8_BAR;
        PG8_WAIT_V(4); PG8_BAR;
        PG8_STAGE(PG8_SB(1, 0), cB + kstep, voffB); PG8_STAGE(PG8_SA(1, 0), cA + kstep, voffA); PG8_STAGE(PG8_SB(1, 1), cB + hstepB + kstep, voffB);
        PG8_WAIT_V(6); PG8_BAR;
    }
    for (;;) {
        const bool has_next = S.next(ui + 1, nxt);
        const char* nA = has_next ? (const char*)(nxt.half ? g.A2 : g.A) + (size_t)nxt.pm * tstep : cA; const char* nB = has_next ? (const char*)(nxt.half ? g.Bt2 : g.Bt) + (size_t)nxt.pn * tstep : cB;
        for (int t = 0; t < nt; t += 2) {
            const bool last = (t == nt - 2);
            const char* a1 = cA + (size_t)(t + 1) * kstep;
            const char* a2 = last ? nA : cA + (size_t)(t + 2) * kstep; const char* b2 = last ? nB : cB + (size_t)(t + 2) * kstep;
            const char* a3 = a2 + kstep; const char* b3 = b2 + kstep;
            if (last && has_next) S.a_ready(nxt);
            if constexpr (SP2) {
            PG8_LDB(B0, 0, 0); PG8_LDB(B1, 0, 1); PG8_SCHED; PG8_LDA(At, 0, 0); PG8_STAGE(PG8_SA(1, 1), a1 + hstep, voffA);
            PG8_WAIT_V(8); PG8_WAIT_L(0); PG8_BAR; PG8_MMA(0, 0, At, B0); PG8_MMA(0, 1, At, B1); PG8_BAR; PG8_SCHED;
            PG8_LDA(At, 0, 1); PG8_STAGE(PG8_SB(0, 0), b2, voffB); PG8_STAGE(PG8_SB(0, 1), b2 + hstepB, voffB); PG8_STAGE(PG8_SA(0, 0), a2, voffA);
            PG8_WAIT_V(8); PG8_WAIT_L(0); PG8_BAR; PG8_MMA(1, 0, At, B0); PG8_MMA(1, 1, At, B1); PG8_BAR; PG8_SCHED;
            PG8_LDB(B0, 1, 0); PG8_LDB(B1, 1, 1); PG8_SCHED; PG8_LDA(At, 1, 0); PG8_STAGE(PG8_SA(0, 1), a2 + hstep, voffA);
            PG8_WAIT_V(8); PG8_WAIT_L(0); PG8_BAR; PG8_MMA(0, 0, At, B0); PG8_MMA(0, 1, At, B1); PG8_BAR; PG8_SCHED;
            PG8_LDA(At, 1, 1); PG8_STAGE(PG8_SB(1, 0), b3, voffB); PG8_STAGE(PG8_SB(1, 1), b3 + hstepB, voffB); PG8_STAGE(PG8_SA(1, 0), a3, voffA);
            PG8_WAIT_V(8); PG8_WAIT_L(0); PG8_BAR; PG8_MMA(1, 0, At, B0); PG8_MMA(1, 1, At, B1); PG8_BAR; PG8_SCHED;
            } else {
            PG8_LDB(B0, 0, 0); PG8_SCHED; PG8_LDA(At, 0, 0); PG8_STAGE(PG8_SA(1, 1), a1 + hstep, voffA);
            PG8_WAIT_L(8); PG8_BAR; PG8_WAIT_L(0); PG8_MMA(0, 0, At, B0); PG8_BAR; PG8_SCHED;
            PG8_LDB(B1, 0, 1); PG8_STAGE(PG8_SB(0, 0), b2, voffB);
            PG8_BAR; PG8_WAIT_L(0); PG8_MMA(0, 1, At, B1); PG8_BAR;
            PG8_LDA(At, 0, 1); PG8_STAGE(PG8_SA(0, 0), a2, voffA);
            PG8_BAR; PG8_WAIT_L(0); PG8_MMA(1, 0, At, B0); PG8_BAR; PG8_SCHED;
            PG8_STAGE(PG8_SB(0, 1), b2 + hstepB, voffB);
            PG8_WAIT_V(6); PG8_BAR; PG8_MMA(1, 1, At, B1); PG8_BAR;
            PG8_LDB(B0, 1, 0); PG8_SCHED; PG8_LDA(At, 1, 0); PG8_STAGE(PG8_SA(0, 1), a2 + hstep, voffA);
            PG8_WAIT_L(8); PG8_BAR; PG8_WAIT_L(0); PG8_MMA(0, 0, At, B0); PG8_BAR; PG8_SCHED;
            PG8_LDB(B1, 1, 1); PG8_STAGE(PG8_SB(1, 0), b3, voffB);
            PG8_BAR; PG8_WAIT_L(0); PG8_MMA(0, 1, At, B1); PG8_BAR;
            PG8_LDA(At, 1, 1); PG8_STAGE(PG8_SA(1, 0), a3, voffA);
            PG8_BAR; PG8_WAIT_L(0); PG8_MMA(1, 0, At, B0); PG8_BAR; PG8_SCHED;
            PG8_STAGE(PG8_SB(1, 1), b3 + hstepB, voffB);
            PG8_WAIT_V(6); PG8_BAR; PG8_MMA(1, 1, At, B1); PG8_BAR;
            }
        }
        if constexpr (F8) asm volatile("s_nop 15\n\ts_nop 15\n\ts_nop 15\n\ts_nop 15\n\ts_nop 15" ::: "memory");
        if constexpr (ALIGN_EPI) { if (wr == 0) PG8_BAR; }
        if constexpr (!Epi::AFTER_DRAIN) { E(acc, cur, wr, wc, fr, fq); S.done(cur); }
        if (!has_next) break;
        if (!(Epi::HAS_MID && cur.half == 0 && nxt.half == 1))
#pragma unroll
        for (int a = 0; a < 2; ++a)
#pragma unroll
            for (int b = 0; b < 2; ++b)
#pragma unroll
                for (int m = 0; m < 4; ++m)
#pragma unroll
                    for (int n = 0; n < 2; ++n) acc[a][b][m][n] = (f32x4){0.f, 0.f, 0.f, 0.f};
        cur = nxt; cA = nA; cB = nB; ++ui;
        if constexpr (ALIGN_EPI) { if (wr == 1) PG8_BAR; }
    }
    PG8_WAIT_V(0);
    if constexpr (!ALIGN_EPI) { if (wr == 0) PG8_BAR; }
    PG8_BAR;
    if constexpr (Epi::AFTER_DRAIN) { E.fused(acc, cur, wr, wc, fr, fq, lds, wid, lane); S.done(cur); }
#undef PG8_SA
#undef PG8_SB
#undef PG8_STAGE
#undef PG8_LDA
#undef PG8_LDB
#undef PG8_MMA
#undef PG8_WAIT_V
#undef PG8_WAIT_L
#undef PG8_BAR
#undef PG8_SCHED
}
}

namespace cg = cooperative_groups;
#define LAS __attribute__((address_space(3)))
typedef unsigned short bf16_t;
typedef short bf16x8 __attribute__((ext_vector_type(8)));
typedef float f32x4 __attribute__((ext_vector_type(4)));
typedef float f32x2 __attribute__((ext_vector_type(2)));
typedef float f32x16 __attribute__((ext_vector_type(16)));
typedef unsigned u32x4 __attribute__((ext_vector_type(4)));
typedef unsigned u32x2 __attribute__((ext_vector_type(2)));
typedef int i32x4 __attribute__((ext_vector_type(4)));

constexpr int T_TOK = 32768, DM = 1024, NZ = 7168, SEQ = 4096, NBATCH = 8, NHEAD = 8, HD = 128;
constexpr int NWAVES = 8, NTHR = 512;
constexpr float LN_EPS = 1e-5f;
constexpr float ALPHA = 1.189207115002721f;
constexpr float ATT_SCALE = 0.08838834764831845f;
constexpr int LUTN = 1280, LUT_OFF = 256;
constexpr int NPAIR = 128;
constexpr size_t MiB = 1u << 20;
constexpr size_t WS_WIN_T = 1 * MiB, WS_PA_T = 15 * MiB, WS_PB_T = 17 * MiB, WS_WOUT_T = 19 * MiB, WS_WQ2_T = 21 * MiB, WS_WPLE_T = 27 * MiB;
constexpr size_t WS_LUT = 27 * MiB + 512 * 1024, WS_KSUM = 28 * MiB;
constexpr size_t WS_PU = 32 * MiB, WS_PV = 48 * MiB, WS_H8 = 64 * MiB, WS_W = 80 * MiB, WS_PB16 = 96 * MiB;
constexpr size_t WS_R0 = 112 * MiB, WS_R1 = 176 * MiB, WS_R2 = 240 * MiB, WS_R3 = 304 * MiB, WS_R4 = 368 * MiB, WS_R5 = 432 * MiB, WS_END = 496 * MiB;
constexpr int LDS_BYTES = 147456;
constexpr int LDS_BAR_OFF = LDS_BYTES - 16;
constexpr size_t WS_BAR = 65536, WS_BAR_BYTES = 262144;

struct Args { const float* in[23]; float* out; unsigned char* ws; int ph_lo, ph_hi, li, pad; };
typedef const __attribute__((address_space(4))) Args* ArgsP;
__device__ __forceinline__ ArgsP args_ptr() { ArgsP p = (ArgsP)__builtin_amdgcn_kernarg_segment_ptr(); asm volatile("" : "+s"(p)); return p; }

#define XB_TMO      128
#define XB_XCNT(j)  (256  + 64 * (j))
#define XB_XSUB(j)  (1280 + 64 * (j))
#define XB_XGEN(j)  (2304 + 64 * (j))
#define XB_TOP      3328
#define XB_TOPGEN   3392
#define XCD_BAR_WORDS 3456
#define XB_SPIN_CAP (1u << 18)

__device__ __forceinline__ unsigned xb_ld(unsigned* p)              { return __hip_atomic_load(p, __ATOMIC_RELAXED, __HIP_MEMORY_SCOPE_AGENT); }
__device__ __forceinline__ unsigned xb_add(unsigned* p, unsigned v) { return __hip_atomic_fetch_add(p, v, __ATOMIC_RELAXED, __HIP_MEMORY_SCOPE_AGENT); }
__device__ __forceinline__ unsigned xb_xcc_id() { return (unsigned)__builtin_amdgcn_s_getreg((3 << 11) | 20) & 0xFu; }
#define XB_SPIN(cond, bar) do { unsigned _sp = 0; while (cond) { __builtin_amdgcn_s_sleep(1); \
    if ((++_sp & 255u) == 0u) { if (xb_ld(&(bar)[XB_TMO])) break; if (_sp > XB_SPIN_CAP) { atomicAdd(&(bar)[XB_TMO], 1u); break; } } } } while (0)

struct XcdBarrier {
    unsigned* bar; unsigned x;
    volatile LAS unsigned* st;
};

__device__ __forceinline__ XcdBarrier xcd_barrier_post(unsigned* bar, volatile LAS unsigned* st) {
    XcdBarrier b; b.bar = bar; b.x = xb_xcc_id(); b.st = st;
    if (threadIdx.x == 0) (void)xb_add(&bar[XB_XCNT(b.x)], 1u);
    return b;
}
__device__ __forceinline__ void xcd_barrier_complete(unsigned* bar, unsigned x, unsigned& nloc, unsigned& nx) {
    const unsigned G = gridDim.x * gridDim.y * gridDim.z;
    unsigned sum, cnt, mine, sp = 0u;
    for (;;) {
        sum = 0u; cnt = 0u; mine = 0u;
#pragma unroll
        for (unsigned j = 0; j < 16; ++j) { const unsigned c = xb_ld(&bar[XB_XCNT(j)]); sum += c; cnt += (c > 0u) ? 1u : 0u; mine = (j == x) ? c : mine; }
        if (sum == G) break;
        __builtin_amdgcn_s_sleep(1);
        if ((++sp & 255u) == 0u) { if (xb_ld(&bar[XB_TMO])) break; if (sp > XB_SPIN_CAP) { atomicAdd(&bar[XB_TMO], 1u); break; } }
    }
    nloc = mine > 0u ? mine : 1u; nx = cnt > 0u ? cnt : 1u;
}

__device__ __forceinline__ void xcd_barrier(const XcdBarrier& b) {
    asm volatile("s_waitcnt vmcnt(0)" ::: "memory");
    __syncthreads();
    if (threadIdx.x == 0) {
        unsigned* bar = b.bar;
        __builtin_amdgcn_s_waitcnt(0);
        unsigned nloc = b.st[0], nx = b.st[1];
        if (nloc == 0u) { xcd_barrier_complete(bar, b.x, nloc, nx); b.st[0] = nloc; b.st[1] = nx; }
        const unsigned old = xb_add(&bar[XB_XSUB(b.x)], 1u);
        const unsigned gen = old / nloc;
        if (old + 1u == (gen + 1u) * nloc) {
            __builtin_amdgcn_fence(__ATOMIC_RELEASE, "agent");
            asm volatile("s_waitcnt vmcnt(0)" ::: "memory");
            const unsigned og = xb_add(&bar[XB_TOP], 1u);
            const unsigned tg = og / nx;
            if (og + 1u == (tg + 1u) * nx) xb_add(&bar[XB_TOPGEN], 1u);
            else XB_SPIN(xb_ld(&bar[XB_TOPGEN]) == tg, bar);
            __builtin_amdgcn_fence(__ATOMIC_ACQUIRE, "agent");
            xb_add(&bar[XB_XGEN(b.x)], 1u);
            asm volatile("s_waitcnt vmcnt(0)" ::: "memory");
        } else {
            XB_SPIN(xb_ld(&bar[XB_XGEN(b.x)]) == gen, bar);
            __builtin_amdgcn_fence(__ATOMIC_ACQUIRE, "agent");
            asm volatile("s_waitcnt vmcnt(0)" ::: "memory");
        }
    }
    __syncthreads();
}

__device__ __forceinline__ float bf_lo(unsigned w) { return __uint_as_float(w << 16); }
__device__ __forceinline__ float bf_hi(unsigned w) { return __uint_as_float(w & 0xffff0000u); }
__device__ __forceinline__ float bf2f(bf16_t b) { return __uint_as_float(((unsigned)b) << 16); }
typedef __bf16 bf16x2_t __attribute__((ext_vector_type(2)));
__device__ __forceinline__ unsigned pkbf(float lo, float hi) { const f32x2 v = {lo, hi}; const bf16x2_t b = __builtin_convertvector(v, bf16x2_t); return __builtin_bit_cast(unsigned, b); }
__device__ __forceinline__ bf16_t f2bf(float f) { return (bf16_t)(pkbf(f, 0.f) & 0xffffu); }
__device__ __forceinline__ float wave_sum(float v) {
#pragma unroll
    for (int o = 1; o < 64; o <<= 1) v += __shfl_xor(v, o);
    return v;
}
__device__ __forceinline__ float wave_max(float v) {
#pragma unroll
    for (int o = 1; o < 64; o <<= 1) v = fmaxf(v, __shfl_xor(v, o));
    return v;
}
__device__ __forceinline__ float sigmoidf_fast(float x) { return __builtin_amdgcn_rcpf(1.0f + __builtin_amdgcn_exp2f(-1.4426950408889634f * x)); }
__device__ __forceinline__ float gelu_erf(float x) { return 0.5f * x * (1.0f + erff(x * 0.70710678118654752f)); }
__device__ __forceinline__ int t5_bucket(int d) {
    const int n = d > 0 ? d : 0;
    if (n < 16) return n;
    const float v = logf((float)n * (1.0f / 16.0f)) / 4.1588830833596715f * 16.0f;
    int b = 16 + (int)(v + 1e-5f);
    return b < 31 ? b : 31;
}

__device__ __forceinline__ void p0_transpose_item(const float* __restrict__ W, int K, int N, bf16_t* WT, int row_off, LAS float* scr, int item, int lane, int ldk = 0, int koff = 0) {
    const int nblk = N / 32, kb = item / nblk, nb = item % nblk, k0 = 64 * kb, n0 = 32 * nb;
#pragma unroll 8
    for (int i = 0; i < 32; ++i) { const int kk = 2 * i + (lane >> 5); scr[kk * 33 + (lane & 31)] = W[(size_t)(k0 + kk) * N + n0 + (lane & 31)]; }
    asm volatile("s_waitcnt lgkmcnt(0)" ::: "memory");
    const int c = lane & 7;
#pragma unroll
    for (int j = 0; j < 4; ++j) { const int n = (lane >> 3) + 8 * j; const LAS float* s = scr + (8 * c) * 33 + n;
        u32x4 o; o.x = pkbf(s[0 * 33], s[1 * 33]); o.y = pkbf(s[2 * 33], s[3 * 33]); o.z = pkbf(s[4 * 33], s[5 * 33]); o.w = pkbf(s[6 * 33], s[7 * 33]);
        *(u32x4*)(WT + (size_t)(row_off + n0 + n) * (ldk ? ldk : K) + koff + k0 + 8 * c) = o; }
    asm volatile("s_waitcnt lgkmcnt(0)" ::: "memory");
}
constexpr float WIN_SCALE = 64.0f;
__device__ __forceinline__ void p0_transpose_item_f8(const float* __restrict__ W, int K, int N, unsigned char* WT, float scale, LAS float* scr, int item, int lane) {
    const int nblk = N / 32, kb = item / nblk, nb = item % nblk, k0 = 64 * kb, n0 = 32 * nb;
#pragma unroll 8
    for (int i = 0; i < 32; ++i) { const int kk = 2 * i + (lane >> 5); scr[kk * 33 + (lane & 31)] = W[(size_t)(k0 + kk) * N + n0 + (lane & 31)]; }
    asm volatile("s_waitcnt lgkmcnt(0)" ::: "memory");
    const int c = lane & 7;
#pragma unroll
    for (int j = 0; j < 4; ++j) { const int n = (lane >> 3) + 8 * j; const LAS float* s = scr + (8 * c) * 33 + n;
        int p0 = __builtin_amdgcn_cvt_pk_fp8_f32(s[0 * 33] * scale, s[1 * 33] * scale, 0, false); p0 = __builtin_amdgcn_cvt_pk_fp8_f32(s[2 * 33] * scale, s[3 * 33] * scale, p0, true);
        int p1 = __builtin_amdgcn_cvt_pk_fp8_f32(s[4 * 33] * scale, s[5 * 33] * scale, 0, false); p1 = __builtin_amdgcn_cvt_pk_fp8_f32(s[6 * 33] * scale, s[7 * 33] * scale, p1, true);
        *(u32x2*)(WT + (size_t)(n0 + n) * K + k0 + 8 * c) = (u32x2){(unsigned)p0, (unsigned)p1}; }
    asm volatile("s_waitcnt lgkmcnt(0)" ::: "memory");
}
__device__ __forceinline__ void cvt_stream(const float* __restrict__ src, bf16_t* dst, size_t n8, size_t gtid, size_t gthreads, int s_lo = 0, int s_hi = 1 << 30) {
    for (size_t i = gtid + (size_t)s_lo * gthreads; i < n8 && i < gtid + (size_t)s_hi * gthreads; i += gthreads) {
        const f32x4 a = *(const f32x4*)(src + i * 8), b = *(const f32x4*)(src + i * 8 + 4);
        u32x4 o; o.x = pkbf(a[0], a[1]); o.y = pkbf(a[2], a[3]); o.z = pkbf(b[0], b[1]); o.w = pkbf(b[2], b[3]);
        *(u32x4*)(dst + i * 8) = o;
    }
}
constexpr float PEER_U_SCALE = 800.0f, PEER_H_SCALE = 20.0f, PEER_V_SCALE = 16.0f;
__device__ __forceinline__ unsigned pack_i8x4(f32x4 v) {
    int q[4];
#pragma unroll
    for (int i = 0; i < 4; ++i) { int t = (int)__builtin_rintf(v[i]); t = t < -127 ? -127 : (t > 127 ? 127 : t); q[i] = t & 0xff; }
    return (unsigned)(q[0] | (q[1] << 8) | (q[2] << 16) | (q[3] << 24));
}
__device__ __forceinline__ void cvt_stream_i8(const float* __restrict__ src, unsigned char* dst, size_t n16, float scale, size_t gtid, size_t gthreads, int s_lo = 0, int s_hi = 1 << 30) {
    for (size_t i = gtid + (size_t)s_lo * gthreads; i < n16 && i < gtid + (size_t)s_hi * gthreads; i += gthreads) { u32x4 o;
#pragma unroll
        for (int q = 0; q < 4; ++q) o[q] = pack_i8x4(*(const f32x4*)(src + i * 16 + q * 4) * scale);
        *(u32x4*)(dst + ((((i & 63) >> 3) * (size_t)16384 + (i >> 6)) * 128 + (i & 7) * 16)) = o; }
}
template <bool SLAB = true> __device__ __forceinline__ void cvt_stream_fp8(const float* __restrict__ src, unsigned char* dst, size_t n16, float scale, size_t gtid, size_t gthreads, int s_lo = 0, int s_hi = 1 << 30) {
    for (size_t i = gtid + (size_t)s_lo * gthreads; i < n16 && i < gtid + (size_t)s_hi * gthreads; i += gthreads) { u32x4 o;
#pragma unroll
        for (int q = 0; q < 4; ++q) { const f32x4 v = *(const f32x4*)(src + i * 16 + q * 4) * scale; int p = __builtin_amdgcn_cvt_pk_fp8_f32(v[0], v[1], 0, false); p = __builtin_amdgcn_cvt_pk_fp8_f32(v[2], v[3], p, true); o[q] = (unsigned)p; }
        *(u32x4*)(dst + (SLAB ? ((((i & 63) >> 3) * (size_t)16384 + (i >> 6)) * 128 + (i & 7) * 16) : i * 16)) = o; }
}
__device__ __forceinline__ void peer_tables(ArgsP a, int tid, int s_lo, int s_hi) {
    unsigned char* ws = a->ws; const size_t gtid = (size_t)blockIdx.x * NTHR + tid, gth = (size_t)gridDim.x * NTHR;
    cvt_stream_i8(a->in[16], ws + WS_PU, (size_t)16384 * 1024 / 16, PEER_U_SCALE, gtid, gth, s_lo, s_hi);
    cvt_stream_fp8(a->in[17], ws + WS_PV, (size_t)16384 * 1024 / 16, PEER_V_SCALE, gtid, gth, s_lo, s_hi);
}
__device__ __forceinline__ void phase0(ArgsP a, LAS unsigned char* lds, int tid, int lane, int wave) {
    unsigned char* ws = a->ws;
    const int G = gridDim.x, gw = blockIdx.x * NWAVES + wave, NGW = G * NWAVES;
    {   LAS float* scr = (LAS float*)(lds + wave * 16384);
        constexpr int I_IN = (1024 / 64) * (7168 / 32);
        for (int it = gw; it < I_IN; it += NGW) p0_transpose_item_f8(a->in[2], 1024, 7168, ws + WS_WIN_T, WIN_SCALE, scr, it, lane);
    }
    {   const size_t gtid = (size_t)blockIdx.x * NTHR + tid, gth = (size_t)G * NTHR;
        cvt_stream_fp8<false>(a->in[0], ws + WS_R0, (size_t)T_TOK * DM / 16, 1.0f, gtid, gth);
    }
}
__device__ __forceinline__ void phase0_deferred(ArgsP a, LAS unsigned char* lds, int tid, int lane, int wave, int part, int cls) {
    unsigned char* ws = a->ws;
    const int G = gridDim.x, gw = blockIdx.x * NWAVES + wave, NGW = G * NWAVES;
    const size_t gtid = (size_t)blockIdx.x * NTHR + tid, gth = (size_t)G * NTHR;
    const int nstep = (int)(((size_t)16384 * 1024 / 16 + gth - 1) / gth);
    const int cut = nstep * cls / 8, s_lo = part ? cut : 0, s_hi = part ? nstep : cut;
    cvt_stream(a->in[1], (bf16_t*)(ws + WS_PB16), (size_t)T_TOK * 256 / 8, gtid, gth, s_lo, s_hi);
    peer_tables(a, tid, s_lo, s_hi);
    if ((cls >= 4) != (part == 0)) return;
    __syncthreads();
    {
        LAS float* scr = (LAS float*)(lds + wave * 16384);
        constexpr int I_SQ = (1024 / 64) * (1024 / 32), I_PLE = (256 / 64) * (1024 / 32);
        constexpr int NIT = 4 * I_SQ + I_PLE;
        for (int it = gw; it < NIT; it += NGW) {
            int r = it;
            if (r < I_SQ) { p0_transpose_item(a->in[8], 1024, 1024, (bf16_t*)(ws + WS_PA_T), 0, scr, r, lane); continue; } r -= I_SQ;
            if (r < I_SQ) { p0_transpose_item(a->in[9], 1024, 1024, (bf16_t*)(ws + WS_PB_T), 0, scr, r, lane); continue; } r -= I_SQ;
            if (r < I_SQ) { p0_transpose_item(a->in[10], 1024, 1024, (bf16_t*)(ws + WS_WOUT_T), 0, scr, r, lane); continue; } r -= I_SQ;
            if (r < I_SQ) { p0_transpose_item(a->in[19], 1024, 1024, (bf16_t*)(ws + WS_WQ2_T), 2048, scr, r, lane); continue; } r -= I_SQ;
            p0_transpose_item(a->in[18], 256, 1024, (bf16_t*)(ws + WS_WPLE_T), 0, scr, r, lane);
        }
    }
    __syncthreads();
    {
        LAS float* sk = (LAS float*)lds;
        LAS float* wq = sk + 128 * 132;
        const float* WQ = a->in[14]; const float* SK = a->in[15]; bf16_t* W2 = (bf16_t*)(ws + WS_WQ2_T);
        for (int item = blockIdx.x; item < 256; item += G) {
            const int hp = item >> 4, d0 = (item & 15) * 64, p = hp & 1;
#pragma unroll
            for (int i = 0; i < 8; ++i) { const int f = tid + 512 * i, n = f >> 5, k4 = f & 31; *(LAS f32x4*)(sk + n * 132 + k4 * 4) = *(const f32x4*)(SK + (size_t)p * 16384 + n * 128 + k4 * 4); }
#pragma unroll
            for (int i = 0; i < 4; ++i) { const int f = tid + 512 * i, dd = f >> 5, k4 = f & 31; *(LAS f32x4*)(wq + dd * 132 + k4 * 4) = *(const f32x4*)(WQ + (size_t)(d0 + dd) * 2048 + hp * 128 + k4 * 4); }
            __syncthreads();
            const int n = tid & 127, dg = tid >> 7;
            float acc[16];
#pragma unroll
            for (int j = 0; j < 16; ++j) acc[j] = 0.f;
            for (int k = 0; k < 128; k += 4) { const f32x4 s = *(const LAS f32x4*)(sk + n * 132 + k);
#pragma unroll
                for (int j = 0; j < 16; ++j) { const f32x4 w = *(const LAS f32x4*)(wq + (dg * 16 + j) * 132 + k); acc[j] += (s[0] * w[0] + s[1] * w[1]) + (s[2] * w[2] + s[3] * w[3]); } }
            u32x4 o0, o1;
            o0.x = pkbf(acc[0], acc[1]); o0.y = pkbf(acc[2], acc[3]); o0.z = pkbf(acc[4], acc[5]); o0.w = pkbf(acc[6], acc[7]);
            o1.x = pkbf(acc[8], acc[9]); o1.y = pkbf(acc[10], acc[11]); o1.z = pkbf(acc[12], acc[13]); o1.w = pkbf(acc[14], acc[15]);
            bf16_t* dst = W2 + (size_t)(hp * 128 + n) * 1024 + d0 + dg * 16;
            *(u32x4*)dst = o0; *(u32x4*)(dst + 8) = o1;
            __syncthreads();
        }
    }
    {
        float* lut = (float*)(ws + WS_LUT); const float* rb = a->in[13];
        for (size_t i = gtid; i < (size_t)NHEAD * LUTN; i += gth) { const int h = (int)(i / LUTN), j = (int)(i % LUTN); lut[i] = rb[t5_bucket(j - LUT_OFF) * NHEAD + h]; }
    }
    __syncthreads();
}

template <int ND> __device__ __forceinline__ void store_line_pair(unsigned char* base, unsigned off, unsigned pitch8, u32x4 w0, u32x4 w1, bool hiF) {
    u32x4 vA, vB;
#pragma unroll
    for (int j = 0; j < ND; ++j) { const unsigned send = hiF ? w0[j] : w1[j]; const unsigned recv = (unsigned)__builtin_amdgcn_mov_dpp((int)send, 0x128, 0xF, 0xF, true);
        vA[j] = hiF ? recv : w0[j]; vB[j] = hiF ? w1[j] : recv; }
    if (ND == 4) { __builtin_nontemporal_store(vA, (u32x4*)(base + off)); __builtin_nontemporal_store(vB, (u32x4*)(base + (off + pitch8))); }
    else { __builtin_nontemporal_store((u32x2){vA[0], vA[1]}, (u32x2*)(base + off)); __builtin_nontemporal_store((u32x2){vB[0], vB[1]}, (u32x2*)(base + (off + pitch8))); }
}
struct EpiZ {
    static constexpr bool PERM = true, AFTER_DRAIN = false, HAS_MID = false;
    bf16_t* w5; bf16_t* g2; const float* bias; float ascale;
    __device__ __forceinline__ void run(const int ACT, const bool KS, const f32x4 (&acc)[2][2][4][2], bf16_t* base, int pm, int colt, int bcolt, int wr, int wc, int fr, int fq) const {
        const int row0 = pm * 256 + wr * 64 + fr, col0 = colt + wc * 64 + 8 * fq, bcol0 = bcolt + wc * 64 + 8 * fq;
        const bool hiF = (fr & 8) != 0; const int rowp = pm * 256 + wr * 64 + (fr & 7), colp = col0 + (hiF ? 32 : 0);
        const f32x4 b00 = *(const f32x4*)(bias + bcol0), b01 = *(const f32x4*)(bias + bcol0 + 4), b10 = *(const f32x4*)(bias + bcol0 + 32), b11 = *(const f32x4*)(bias + bcol0 + 36);
#pragma unroll
        for (int ai = 0; ai < 2; ++ai)
#pragma unroll
            for (int m = 0; m < 4; ++m) { u32x4 w[2];
#pragma unroll
                for (int bj = 0; bj < 2; ++bj) {
                    f32x4 v0 = acc[ai][bj][m][0] * ascale + (bj ? b10 : b00), v1 = acc[ai][bj][m][1] * ascale + (bj ? b11 : b01);
                    if (ACT == 1) { const f32x2 a = pg8::gelu_pk((f32x2){v0[0], v0[1]}), b = pg8::gelu_pk((f32x2){v0[2], v0[3]}), c = pg8::gelu_pk((f32x2){v1[0], v1[1]}), d = pg8::gelu_pk((f32x2){v1[2], v1[3]});
                        v0 = (f32x4){a.x, a.y, b.x, b.y}; v1 = (f32x4){c.x, c.y, d.x, d.y}; }
                    if (ACT == 2) {
                        unsigned q0 = 0, q1 = 0;
#pragma unroll
                        for (int j = 0; j < 4; ++j) { int t0 = (int)(sigmoidf_fast(v0[j]) * 255.0f + 0.5f), t1 = (int)(sigmoidf_fast(v1[j]) * 255.0f + 0.5f);
                            t0 = t0 < 1 ? 1 : (t0 > 255 ? 255 : t0); t1 = t1 < 1 ? 1 : (t1 > 255 ? 255 : t1); q0 |= (unsigned)t0 << (8 * j); q1 |= (unsigned)t1 << (8 * j); }
                        w[bj].x = q0; w[bj].y = q1; w[bj].z = 0u; w[bj].w = 0u;
                    } else { w[bj].x = pkbf(v0[0], v0[1]); w[bj].y = pkbf(v0[2], v0[3]); w[bj].z = pkbf(v1[0], v1[1]); w[bj].w = pkbf(v1[2], v1[3]); }
                }
                const unsigned eo = (unsigned)(rowp + ai * 128 + m * 16) * 1024u + (unsigned)colp;
                if (ACT == 2) store_line_pair<2>((unsigned char*)base, eo, 8u * 1024u, w[0], w[1], hiF);
                else store_line_pair<4>((unsigned char*)base, eo * 2u, 8u * 2048u, w[0], w[1], hiF);
            }
        if (KS) {
#pragma unroll
            for (int bj = 0; bj < 2; ++bj)
#pragma unroll
                for (int n = 0; n < 2; ++n) {
                    f32x4 cs = acc[0][bj][0][n];
#pragma unroll
                    for (int q = 1; q < 8; ++q) cs += acc[q >> 2][bj][q & 3][n];
                    cs = cs * ascale + *(const f32x4*)(bias + bcol0 + bj * 32 + 4 * n) * 8.0f;
#pragma unroll
                    for (int s = 1; s < 16; s <<= 1)
#pragma unroll
                        for (int j = 0; j < 4; ++j) cs[j] += __shfl_xor(cs[j], s);
                    if (fr == 0) *(f32x4*)((float*)((unsigned char*)w5 - WS_R1 + WS_KSUM) + (size_t)(2 * pm + wr) * 1024 + col0 + bj * 32 + 4 * n) = cs; }
        }
    }
    __device__ __forceinline__ void operator()(const f32x4 (&acc)[2][2][4][2], const pg8::Unit& u, int wr, int wc, int fr, int fq) const {
        const int t = u.pn >> 2, colt = (u.pn & 3) * 256, bcolt = u.pn * 256;
        bf16_t* base = (t < 5) ? w5 + (size_t)t * ((size_t)T_TOK * 1024) : (bf16_t*)((unsigned char*)g2 + (size_t)(t - 5) * ((size_t)T_TOK * 1024));
        run(t < 2 ? 1 : (t >= 5 ? 2 : 0), t == 3, acc, base, u.pm, colt, bcolt, wr, wc, fr, fq);
    }
};
template <int MODE> struct EpiMix {
    static constexpr bool PERM = true, AFTER_DRAIN = false, HAS_MID = false;
    bf16_t* out; const bf16_t* g1; const bf16_t* add;
    __device__ __forceinline__ void operator()(const f32x4 (&acc)[2][2][4][2], const pg8::Unit& u, int wr, int wc, int fr, int fq) const {
        const int row0 = u.pm * 256 + wr * 64 + fr, col0 = u.pn * 256 + wc * 64 + 8 * fq;
#pragma unroll
        for (int ai = 0; ai < 2; ++ai)
#pragma unroll
            for (int m = 0; m < 4; ++m) { const size_t ro = (size_t)(row0 + ai * 128 + m * 16) * 1024 + col0;
                u32x4 wq[2];
#pragma unroll
                for (int bj = 0; bj < 2; ++bj) { f32x4 v0 = acc[ai][bj][m][0], v1 = acc[ai][bj][m][1];
                    if (MODE >= 1) { const u32x4 g = *(const u32x4*)(g1 + ro + bj * 32);
                        v0[0] *= bf_lo(g.x); v0[1] *= bf_hi(g.x); v0[2] *= bf_lo(g.y); v0[3] *= bf_hi(g.y); v1[0] *= bf_lo(g.z); v1[1] *= bf_hi(g.z); v1[2] *= bf_lo(g.w); v1[3] *= bf_hi(g.w); }
                    if (MODE == 2) { const u32x4 g = *(const u32x4*)(add + ro + bj * 32);
                        v0[0] += bf_lo(g.x); v0[1] += bf_hi(g.x); v0[2] += bf_lo(g.y); v0[3] += bf_hi(g.y); v1[0] += bf_lo(g.z); v1[1] += bf_hi(g.z); v1[2] += bf_lo(g.w); v1[3] += bf_hi(g.w); }
                    wq[bj].x = pkbf(v0[0], v0[1]); wq[bj].y = pkbf(v0[2], v0[3]); wq[bj].z = pkbf(v1[0], v1[1]); wq[bj].w = pkbf(v1[2], v1[3]); }
                store_line_pair<4>((unsigned char*)out, ((unsigned)ro - (unsigned)(fr & 8) * 1020u) * 2u, 8u * 2048u, wq[0], wq[1], (fr & 8) != 0); }
    }
};
struct EpiNull { static constexpr bool PERM = true, AFTER_DRAIN = false, HAS_MID = false; float* sink;
    __device__ __forceinline__ void operator()(const f32x4 (&acc)[2][2][4][2], const pg8::Unit& u, int wr, int wc, int fr, int fq) const { float s = 0.f;
#pragma unroll
        for (int ai = 0; ai < 2; ++ai)
#pragma unroll
            for (int bj = 0; bj < 2; ++bj)
#pragma unroll
                for (int m = 0; m < 4; ++m) s += acc[ai][bj][m][0][0] + acc[ai][bj][m][1][3];
        if (s == 123.456f) sink[0] = s; } };
struct EpiGate {
    static constexpr bool PERM = true, AFTER_DRAIN = false, HAS_MID = true;
    bf16_t* out; const unsigned char* ga; const unsigned char* gb;
    __device__ __forceinline__ void operator()(f32x4 (&acc)[2][2][4][2], const pg8::Unit& u, int wr, int wc, int fr, int fq) const {
        const int row0 = u.pm * 256 + wr * 64 + fr, col0 = u.pn * 256 + wc * 64 + 8 * fq;
#define GB_(x_, k_) ((float)(((x_) >> (8 * (k_))) & 0xffu))
        if (u.half == 0) {
#pragma unroll
            for (int ai = 0; ai < 2; ++ai)
#pragma unroll
                for (int m = 0; m < 4; ++m) { const size_t ro = (size_t)(row0 + ai * 128 + m * 16) * 1024 + col0;
#pragma unroll
                    for (int bj = 0; bj < 2; ++bj) { const u32x2 a = *(const u32x2*)(ga + ro + bj * 32), b = *(const u32x2*)(gb + ro + bj * 32);
                        f32x4& v0 = acc[ai][bj][m][0]; f32x4& v1 = acc[ai][bj][m][1];
#pragma unroll
                        for (int j = 0; j < 4; ++j) { v0[j] *= GB_(a.x, j) * __builtin_amdgcn_rcpf(GB_(b.x, j)); v1[j] *= GB_(a.y, j) * __builtin_amdgcn_rcpf(GB_(b.y, j)); } } }
        } else {
#pragma unroll
            for (int ai = 0; ai < 2; ++ai)
#pragma unroll
                for (int m = 0; m < 4; ++m) { const size_t ro = (size_t)(row0 + ai * 128 + m * 16) * 1024 + col0;
                    u32x4 wq[2];
#pragma unroll
                    for (int bj = 0; bj < 2; ++bj) { const u32x2 g = *(const u32x2*)(gb + ro + bj * 32); const f32x4 v0 = acc[ai][bj][m][0] * (1.0f / 255.0f), v1 = acc[ai][bj][m][1] * (1.0f / 255.0f);
                        wq[bj].x = pkbf(v0[0] * GB_(g.x, 0), v0[1] * GB_(g.x, 1)); wq[bj].y = pkbf(v0[2] * GB_(g.x, 2), v0[3] * GB_(g.x, 3)); wq[bj].z = pkbf(v1[0] * GB_(g.y, 0), v1[1] * GB_(g.y, 1)); wq[bj].w = pkbf(v1[2] * GB_(g.y, 2), v1[3] * GB_(g.y, 3)); }
                    store_line_pair<4>((unsigned char*)out, ((unsigned)ro - (unsigned)(fr & 8) * 1020u) * 2u, 8u * 2048u, wq[0], wq[1], (fr & 8) != 0); }
        }
#undef GB_
    }
};
struct EpiRes {
    static constexpr bool PERM = true, AFTER_DRAIN = false, HAS_MID = false;
    const float* x; bf16_t* out;
    __device__ __forceinline__ void operator()(const f32x4 (&acc)[2][2][4][2], const pg8::Unit& u, int wr, int wc, int fr, int fq) const {
        const int row0 = u.pm * 256 + wr * 64 + fr, col0 = u.pn * 256 + wc * 64 + 8 * fq;
#pragma unroll
        for (int ai = 0; ai < 2; ++ai)
#pragma unroll
            for (int m = 0; m < 4; ++m) { const size_t ro = (size_t)(row0 + ai * 128 + m * 16) * 1024 + col0;
                u32x4 wq[2];
#pragma unroll
                for (int bj = 0; bj < 2; ++bj) {
                    const f32x4 v0 = *(const f32x4*)(x + ro + bj * 32) * ALPHA + acc[ai][bj][m][0], v1 = *(const f32x4*)(x + ro + bj * 32 + 4) * ALPHA + acc[ai][bj][m][1];
                    wq[bj].x = pkbf(v0[0], v0[1]); wq[bj].y = pkbf(v0[2], v0[3]); wq[bj].z = pkbf(v1[0], v1[1]); wq[bj].w = pkbf(v1[2], v1[3]); }
                store_line_pair<4>((unsigned char*)out, ((unsigned)ro - (unsigned)(fr & 8) * 1020u) * 2u, 8u * 2048u, wq[0], wq[1], (fr & 8) != 0); }
    }
};
struct EpiP6 {
    static constexpr bool PERM = true, AFTER_DRAIN = false, HAS_MID = false;
    float* sA; float* sB; bf16_t* e; const float* bpg;
    __device__ __forceinline__ void operator()(const f32x4 (&acc)[2][2][4][2], const pg8::Unit& u, int wr, int wc, int fr, int fq) const {
        const int row0 = u.pm * 256 + wr * 64 + fr;
        if (u.pn < 8) {
            _Float16* base = (_Float16*)((u.pn < 4) ? sA : sB); const int col0 = (u.pn & 3) * 256 + wc * 64 + 8 * fq;
#pragma unroll
            for (int ai = 0; ai < 2; ++ai)
#pragma unroll
                for (int m = 0; m < 4; ++m) { _Float16* rp = base + (size_t)(row0 + ai * 128 + m * 16) * 1024 + col0;
                    u32x4 wq[2];
#pragma unroll
                    for (int bj = 0; bj < 2; ++bj) { const f32x4 v0 = acc[ai][bj][m][0], v1 = acc[ai][bj][m][1];
#define H2_(x_, y_) __builtin_bit_cast(unsigned, __builtin_amdgcn_cvt_pkrtz(__builtin_fminf(__builtin_fmaxf((x_), -65000.0f), 65000.0f), __builtin_fminf(__builtin_fmaxf((y_), -65000.0f), 65000.0f)))
                        wq[bj].x = H2_(v0[0], v0[1]); wq[bj].y = H2_(v0[2], v0[3]); wq[bj].z = H2_(v1[0], v1[1]); wq[bj].w = H2_(v1[2], v1[3]);
#undef H2_
                    }
                    store_line_pair<4>((unsigned char*)base, ((unsigned)(rp - base) - (unsigned)(fr & 8) * 1020u) * 2u, 8u * 2048u, wq[0], wq[1], (fr & 8) != 0); }
        } else {
            const int col0 = (u.pn - 8) * 256 + wc * 64 + 8 * fq;
            f32x4 bv[2][2];
#pragma unroll
            for (int bj = 0; bj < 2; ++bj)
#pragma unroll
                for (int n = 0; n < 2; ++n) bv[bj][n] = *(const f32x4*)(bpg + col0 + bj * 32 + 4 * n);
#pragma unroll
            for (int ai = 0; ai < 2; ++ai)
#pragma unroll
                for (int m = 0; m < 4; ++m) { bf16_t* rp = e + (size_t)(row0 + ai * 128 + m * 16) * 1024 + col0; u32x4 wq[2];
#pragma unroll
                    for (int bj = 0; bj < 2; ++bj) { f32x4 v0 = acc[ai][bj][m][0] + bv[bj][0], v1 = acc[ai][bj][m][1] + bv[bj][1];
                        const u32x4 g = *(const u32x4*)(rp + bj * 32);
#pragma unroll
                        for (int j = 0; j < 4; ++j) { v0[j] = sigmoidf_fast(v0[j]); v1[j] = sigmoidf_fast(v1[j]); }
                        v0[0] *= bf_lo(g.x); v0[1] *= bf_hi(g.x); v0[2] *= bf_lo(g.y); v0[3] *= bf_hi(g.y); v1[0] *= bf_lo(g.z); v1[1] *= bf_hi(g.z); v1[2] *= bf_lo(g.w); v1[3] *= bf_hi(g.w);
                        wq[bj].x = pkbf(v0[0], v0[1]); wq[bj].y = pkbf(v0[2], v0[3]); wq[bj].z = pkbf(v1[0], v1[1]); wq[bj].w = pkbf(v1[2], v1[3]); }
                    store_line_pair<4>((unsigned char*)e, ((unsigned)(rp - e) - (unsigned)(fr & 8) * 1020u) * 2u, 8u * 2048u, wq[0], wq[1], (fr & 8) != 0); }
        }
    }
};

__device__ __forceinline__ void phase2(ArgsP a, LAS unsigned char* lds, int tid, int lane, int wave, bool dummy_out = false) {
    unsigned char* ws = a->ws;
    bf16_t* U = (bf16_t*)(ws + WS_R1); const bf16_t* V = (const bf16_t*)(ws + WS_R2);
    const float* lng = a->in[4]; const float* lnb = a->in[5]; const float* wsp = a->in[6]; const float* bs = a->in[7];
    LAS float* st_mean = (LAS float*)lds; LAS float* st_rstd = st_mean + 128;
    LAS bf16_t* Wt = (LAS bf16_t*)(lds + 1024);
    LAS bf16_t* VnT = Wt + 128 * 136;
    for (int ch = blockIdx.x; ch < T_TOK / 128; ch += gridDim.x) {
        const int t0 = ch * 128;
        for (int r = wave * 16; r < wave * 16 + 16; ++r) {
            const u32x4* vp = (const u32x4*)(V + (size_t)(t0 + r) * 1024) + lane * 2;
            const u32x4 q0 = vp[0], q1 = vp[1];
            float x[16];
            x[0] = bf_lo(q0.x); x[1] = bf_hi(q0.x); x[2] = bf_lo(q0.y); x[3] = bf_hi(q0.y); x[4] = bf_lo(q0.z); x[5] = bf_hi(q0.z); x[6] = bf_lo(q0.w); x[7] = bf_hi(q0.w);
            x[8] = bf_lo(q1.x); x[9] = bf_hi(q1.x); x[10] = bf_lo(q1.y); x[11] = bf_hi(q1.y); x[12] = bf_lo(q1.z); x[13] = bf_hi(q1.z); x[14] = bf_lo(q1.w); x[15] = bf_hi(q1.w);
            float s = 0.f;
#pragma unroll
            for (int j = 0; j < 16; ++j) s += x[j];
            const float mean = wave_sum(s) * (1.0f / 1024.0f);
            float ss = 0.f;
#pragma unroll
            for (int j = 0; j < 16; ++j) { const float d = x[j] - mean; ss += d * d; }
            const float rstd = 1.0f / sqrtf(wave_sum(ss) * (1.0f / 1024.0f) + LN_EPS);
            if (lane == 0) { st_mean[r] = mean; st_rstd[r] = rstd; }
        }
        __syncthreads();
        for (int g = 0; g < 8; ++g) {
            {
                const int trow = tid >> 2, s0 = (tid & 3) * 32; const float* wp = wsp + ((size_t)g * 128 + trow) * 128 + s0;
#pragma unroll
                for (int i = 0; i < 4; ++i) { const f32x4 f0 = *(const f32x4*)(wp + i * 8), f1 = *(const f32x4*)(wp + i * 8 + 4); const int sb = s0 + i * 8;
                    float w[8] = {f0[0], f0[1], f0[2], f0[3], f1[0], f1[1], f1[2], f1[3]};
#pragma unroll
                    for (int j = 0; j < 8; ++j) w[j] = (sb + j <= trow) ? w[j] : 0.f;
                    u32x4 o; o.x = pkbf(w[0], w[1]); o.y = pkbf(w[2], w[3]); o.z = pkbf(w[4], w[5]); o.w = pkbf(w[6], w[7]);
                    *(LAS u32x4*)(Wt + trow * 136 + sb) = o; }
            }
            {
                const int s = tid >> 2, c0 = (tid & 3) * 32; const float mean = st_mean[s], rstd = st_rstd[s];
                const u32x4* vp = (const u32x4*)(V + (size_t)(t0 + s) * 1024 + g * 128 + c0);
#pragma unroll
                for (int i = 0; i < 4; ++i) { const u32x4 q = vp[i]; const int cb = c0 + i * 8;
                    const f32x4 g0 = *(const f32x4*)(lng + g * 128 + cb), g1 = *(const f32x4*)(lng + g * 128 + cb + 4), b0 = *(const f32x4*)(lnb + g * 128 + cb), b1 = *(const f32x4*)(lnb + g * 128 + cb + 4);
                    float x[8] = {bf_lo(q.x), bf_hi(q.x), bf_lo(q.y), bf_hi(q.y), bf_lo(q.z), bf_hi(q.z), bf_lo(q.w), bf_hi(q.w)};
                    const float gg[8] = {g0[0], g0[1], g0[2], g0[3], g1[0], g1[1], g1[2], g1[3]}, bb[8] = {b0[0], b0[1], b0[2], b0[3], b1[0], b1[1], b1[2], b1[3]};
#pragma unroll
                    for (int j = 0; j < 8; ++j) VnT[(cb + j) * 136 + s] = f2bf((x[j] - mean) * rstd * gg[j] + bb[j]); }
            }
            __syncthreads();
            const int tt = wave >> 1, cc = wave & 1, i32 = lane & 31, kq = lane >> 5;
            f32x16 acc0 = {}, acc1 = {};
            for (int ks = 0; ks < 2 * (tt + 1); ++ks) {
                const bf16x8 af = *(const LAS bf16x8*)(Wt + (tt * 32 + i32) * 136 + ks * 16 + kq * 8);
                const bf16x8 b0 = *(const LAS bf16x8*)(VnT + (cc * 64 + i32) * 136 + ks * 16 + kq * 8);
                const bf16x8 b1 = *(const LAS bf16x8*)(VnT + (cc * 64 + 32 + i32) * 136 + ks * 16 + kq * 8);
                acc0 = __builtin_amdgcn_mfma_f32_32x32x16_bf16(af, b0, acc0, 0, 0, 0);
                acc1 = __builtin_amdgcn_mfma_f32_32x32x16_bf16(af, b1, acc1, 0, 0, 0);
            }
#pragma unroll
            for (int r = 0; r < 16; ++r) { const int trow = tt * 32 + (r & 3) + 8 * (r >> 2) + 4 * kq; const float bsv = bs[g * 128 + trow];
                const size_t off = (size_t)(t0 + trow) * 1024 + g * 128 + cc * 64 + i32;
                const float u0 = bf2f(U[off]), u1 = bf2f(U[off + 32]);
                bf16_t* Uo = dummy_out ? (bf16_t*)(ws + WS_END) + (size_t)trow * 1024 + g * 128 + cc * 64 + i32 : U + off;
                Uo[0] = f2bf(u0 * (acc0[r] + bsv)); Uo[32] = f2bf(u1 * (acc1[r] + bsv)); }
            __syncthreads();
        }
    }
}

__device__ __forceinline__ void phase3_naive(ArgsP a, LAS unsigned char* lds, int tid, int lane, int wave) {
    unsigned char* ws = a->ws;
    bf16_t* QO = (bf16_t*)(ws + WS_R3); const bf16_t* Kt = (const bf16_t*)(ws + WS_R4); const bf16_t* Vt = (const bf16_t*)(ws + WS_R5);
    const float* ksum = (const float*)(ws + WS_KSUM); const float* lut = (const float*)(ws + WS_LUT);
    LAS float* lg = (LAS float*)(lds + wave * 5120); LAS float* qs = lg + 1024;
    const int gw = blockIdx.x * NWAVES + wave, NGW = gridDim.x * NWAVES;
    for (int row = gw; row < NBATCH * NHEAD * SEQ; row += NGW) {
        const int t = row & (SEQ - 1), h = (row >> 12) & 7, b = row >> 15, qb = t >> 8;
        const size_t qoff = ((size_t)(b * SEQ + t)) * 1024 + h * 128 + 2 * lane;
        { const unsigned w = *(const unsigned*)(QO + qoff); qs[2 * lane] = bf_lo(w); qs[2 * lane + 1] = bf_hi(w); }
        asm volatile("s_waitcnt lgkmcnt(0)" ::: "memory");
        float gate = -__builtin_inff();
        if (lane < qb) { const float* k0 = ksum + ((size_t)(b * 32 + 2 * lane)) * 1024 + h * 128; const float* k1 = k0 + 1024; float s = 0.f;
            for (int d = 0; d < 128; ++d) s += qs[d] * ((k0[d] + k1[d]) * (1.0f / 256.0f));
            gate = s; }
        const int nsel = qb < 3 ? qb : 3; unsigned selmask = 0;
        for (int r = 0; r < nsel; ++r) { const float m = wave_max(gate); const unsigned long long bal = __ballot(gate == m); const int j = __ffsll((long long)bal) - 1; selmask |= 1u << j; if (lane == j) gate = -__builtin_inff(); }
        float mx = -__builtin_inff();
        { unsigned rem = selmask;
          for (int slot = 0; slot <= nsel; ++slot) { int blk, nkeys; if (slot == 0) { blk = qb; nkeys = (t & 255) + 1; } else { blk = __ffs(rem) - 1; rem &= rem - 1; nkeys = 256; }
            for (int kk = lane; kk < nkeys; kk += 64) { const int s = blk * 256 + kk; const u32x4* kp = (const u32x4*)(Kt + ((size_t)(b * SEQ + s)) * 1024 + h * 128); float dot = 0.f;
#pragma unroll 4
                for (int i = 0; i < 16; ++i) { const u32x4 w = kp[i]; const f32x4 qa = *(const LAS f32x4*)(qs + i * 8), qc = *(const LAS f32x4*)(qs + i * 8 + 4);
                    dot += bf_lo(w.x) * qa[0] + bf_hi(w.x) * qa[1] + bf_lo(w.y) * qa[2] + bf_hi(w.y) * qa[3] + bf_lo(w.z) * qc[0] + bf_hi(w.z) * qc[1] + bf_lo(w.w) * qc[2] + bf_hi(w.w) * qc[3]; }
                const int dd = t - s; const float l = dot * ATT_SCALE + lut[h * LUTN + (dd < 1023 ? dd : 1023) + LUT_OFF];   lg[slot * 256 + kk] = l; mx = fmaxf(mx, l); } } }
        mx = wave_max(mx);
        float sum = 0.f;
        for (int slot = 0; slot <= nsel; ++slot) { const int nkeys = slot == 0 ? (t & 255) + 1 : 256;
            for (int kk = lane; kk < nkeys; kk += 64) { const float e = __expf(lg[slot * 256 + kk] - mx); lg[slot * 256 + kk] = e; sum += e; } }
        sum = wave_sum(sum);
        asm volatile("s_waitcnt lgkmcnt(0)" ::: "memory");
        const float inv = 1.0f / sum; float o0 = 0.f, o1 = 0.f;
        { unsigned rem = selmask;
          for (int slot = 0; slot <= nsel; ++slot) { int blk, nkeys; if (slot == 0) { blk = qb; nkeys = (t & 255) + 1; } else { blk = __ffs(rem) - 1; rem &= rem - 1; nkeys = 256; }
            const bf16_t* vp = Vt + ((size_t)(b * SEQ + blk * 256)) * 1024 + h * 128 + 2 * lane;
            for (int kk = 0; kk < nkeys; ++kk) { const float w = lg[slot * 256 + kk]; const unsigned vv = *(const unsigned*)(vp + (size_t)kk * 1024); o0 += w * bf_lo(vv); o1 += w * bf_hi(vv); } } }
        *(unsigned*)(QO + qoff) = pkbf(o0 * inv, o1 * inv);
    }
}


#ifndef MK_NQR
#define MK_NQR 8
#endif
namespace attn {
constexpr int D = 128, PITCH = 1024;
constexpr float THR = 8.f; constexpr bool WSKIP = false;
constexpr float SCALE = 0.08838834764831845f;
constexpr int NW = 8, QBLK = 32, KVBLK = 64, QB = NW * QBLK;
constexpr int SHM_V = KVBLK * D * 2, SHM_K = KVBLK * D * 2;
constexpr int Q_LDS_OFF = 2 * SHM_V + 2 * SHM_K + NW * 64 * 4;
constexpr int LUT_LDS_OFF = Q_LDS_OFF + NW * 8192;
constexpr int SEL_LDS_OFF = LUT_LDS_OFF + LUTN * 4;
constexpr int LDS_NEED = SEL_LDS_OFF + QB * 4;
typedef short s16x4 __attribute__((ext_vector_type(4)));
template <class A, class Bt> struct same_t { static constexpr bool v = false; };
template <class A> struct same_t<A, A> { static constexpr bool v = true; };
__device__ __forceinline__ unsigned cvtpk(float lo, float hi) { return pkbf(lo, hi); }
#define KSWZ(row, colB) ((row) * 256 + ((colB) ^ (((row) & 7) << 4)))
#define SBAR() __builtin_amdgcn_sched_barrier(0)
__device__ __forceinline__ int v_st(int k, int c) { const int kk = (k & ~0xC) | ((k & 4) << 1) | ((k & 8) >> 1); return ((kk >> 3) * 4 + (c >> 5)) * 512 + ((kk & 7) * 32 + (c & 31)) * 2; }
__device__ __forceinline__ int v_rd_base(int lane) { return ((lane & 3) << 3) | (((lane >> 2) & 3) << 6) | (((lane >> 4) & 1) << 5) | (((lane >> 5) & 1) << 8); }
constexpr int v_rd_off(int d0, int ks, int half) { return d0 * 512 + ks * 4096 + half * 2048; }
__device__ __forceinline__ int crow(int r, int hi) { return (r & 3) + 8 * (r >> 2) + 4 * hi; }

__device__ __forceinline__ bf16x8 pack8(f32x4 a, f32x4 b) {
    u32x4 w = {cvtpk(a[0], a[1]), cvtpk(a[2], a[3]), cvtpk(b[0], b[1]), cvtpk(b[2], b[3])};
    return *reinterpret_cast<bf16x8*>(&w);
}
template <class T> __device__ __forceinline__ bf16x8 load8(const T* p) {
    if constexpr (same_t<T, float>::v) { return pack8(*(const f32x4*)p, *(const f32x4*)(p + 4)); }
    else { return *reinterpret_cast<const bf16x8*>(p); }
}
__device__ __forceinline__ void mask_tile(f32x16& p0, f32x16& p1, int dq, unsigned W) {
    const float NEG = -__builtin_inff();
#pragma unroll
    for (int r = 0; r < 16; ++r) {
        const int c = (r & 3) + 8 * (r >> 2);
        if ((unsigned)(dq - c) >= W) p0[r] = NEG;
        if ((unsigned)(dq - c - 32) >= W) p1[r] = NEG;
    }
}
__device__ __forceinline__ void bias_tile(f32x16& p0, f32x16& p1, const float* lp) {
#pragma unroll
    for (int g = 0; g < 4; ++g) { float b0[4], b1[4];
#pragma unroll
        for (int i = 0; i < 4; ++i) { const int r = 4 * g + i, c = (r & 3) + 8 * (r >> 2); b0[i] = lp[59 - c]; b1[i] = lp[59 - c - 32]; }
#pragma unroll
        for (int i = 0; i < 4; ++i) { p0[4 * g + i] += b0[i]; p1[4 * g + i] += b1[i]; }
        SBAR(); }
}
__device__ __forceinline__ void partialSM(f32x16& p0, f32x16& p1, float cst, float& m_reg, float& mn, float& alpha) {
    float pmax = p0[0]; for (int r = 1; r < 16; ++r) pmax = fmaxf(pmax, p0[r]); for (int r = 0; r < 16; ++r) pmax = fmaxf(pmax, p1[r]);
    { auto rr = __builtin_amdgcn_permlane32_swap(__float_as_uint(pmax), __float_as_uint(pmax), false, false);
      pmax = fmaxf(__uint_as_float(rr[0]), __uint_as_float(rr[1])); }
    pmax += cst;
    constexpr float C2 = 1.4426950408889634f * SCALE;
    if (__builtin_expect(__all((pmax - m_reg) * SCALE <= THR), 1)) { mn = m_reg; alpha = 1.f; }
    else { mn = fmaxf(m_reg, pmax); alpha = __builtin_amdgcn_exp2f((m_reg - mn) * C2); m_reg = mn; }
    const float mnL = (cst - mn) * C2;
    for (int r = 0; r < 16; ++r) p0[r] = fmaf(p0[r], C2, mnL); for (int r = 0; r < 16; ++r) p1[r] = fmaf(p1[r], C2, mnL);
    for (int r = 0; r < 16; ++r) p0[r] = __builtin_amdgcn_exp2f(p0[r]);
}
__device__ __forceinline__ void finishSM(f32x16& p0, f32x16& p1, float alpha, float& l_reg, bf16x8& pa0, bf16x8& pa1, bf16x8& pa2, bf16x8& pa3) {
    for (int r = 0; r < 16; ++r) p1[r] = __builtin_amdgcn_exp2f(p1[r]);
    float ps = 0; for (int r = 0; r < 16; ++r) ps += p0[r]; for (int r = 0; r < 16; ++r) ps += p1[r];
    { auto rr = __builtin_amdgcn_permlane32_swap(__float_as_uint(ps), __float_as_uint(ps), false, false);
      ps = __uint_as_float(rr[0]) + __uint_as_float(rr[1]); }
    l_reg = l_reg * alpha + ps;
#define PK4(P, B_, OUT) do { unsigned a0 = cvtpk(P[B_+0], P[B_+1]), a1 = cvtpk(P[B_+2], P[B_+3]);                          \
        unsigned b0 = cvtpk(P[B_+4], P[B_+5]), b1 = cvtpk(P[B_+6], P[B_+7]);                                             \
        auto r0 = __builtin_amdgcn_permlane32_swap(a0, b0, false, false); auto r1 = __builtin_amdgcn_permlane32_swap(a1, b1, false, false); \
        u32x4 w = {r0[0], r1[0], r0[1], r1[1]}; OUT = *reinterpret_cast<bf16x8*>(&w); } while (0)
    PK4(p0, 0, pa0); PK4(p0, 8, pa1); PK4(p1, 0, pa2); PK4(p1, 8, pa3);
#undef PK4
}
template <int KB, bool SK, int NQR = 0>
__device__ __forceinline__ void qkt(f32x16& p0, f32x16& p1, const char* K_lds, int r32, int hi, const char* Qw, bool act, const bf16x8* qr = nullptr) {
    if (SK && !act) { const float NEG = -__builtin_inff();
#pragma unroll
        for (int r = 0; r < 16; ++r) { p0[r] = NEG; p1[r] = NEG; } return; }
    p0 = f32x16{}; p1 = f32x16{};
    const char* kb[4];
#pragma unroll
    for (int dd = 0; dd < 4; ++dd) kb[dd] = K_lds + KB * SHM_K + KSWZ(r32, (dd * 16 + hi * 8) * 2);
#pragma unroll
    for (int d0 = 0; d0 < 8; ++d0) { const char* a = kb[d0 & 3] + (d0 >> 2) * 128;
        bf16x8 b0 = *reinterpret_cast<const bf16x8*>(a);
        bf16x8 b1 = *reinterpret_cast<const bf16x8*>(a + 32 * 256);
        const bf16x8 qf = (d0 < NQR) ? qr[d0] : *reinterpret_cast<const bf16x8*>(a - (K_lds + KB * SHM_K) + Qw);
        p0 = __builtin_amdgcn_mfma_f32_32x32x16_bf16(b0, qf, p0, 0, 0, 0);
        p1 = __builtin_amdgcn_mfma_f32_32x32x16_bf16(b1, qf, p1, 0, 0, 0); }
}
template <int VB, bool SK>
__device__ __forceinline__ void pv_tile(f32x16* o, int vb0, bf16x8 pa0, bf16x8 pa1, bf16x8 pa2, bf16x8 pa3, bool act) {
    if (SK && !act) return;
#define TRRD(dst, off) asm volatile("ds_read_b64_tr_b16 %0, %1 offset:%2" : "=&v"(dst) : "v"(vb0), "i"(off) : "memory")
#define PV_D0(d0) do { s16x4 l0, l1, l2, l3, h0, h1, h2, h3; constexpr int b_ = VB * SHM_V + v_rd_off(d0, 0, 0);     \
        TRRD(l0, b_); TRRD(h0, b_ + 2048); TRRD(l1, b_ + 4096); TRRD(h1, b_ + 6144); TRRD(l2, b_ + 8192); TRRD(h2, b_ + 10240); TRRD(l3, b_ + 12288); TRRD(h3, b_ + 14336); \
        asm volatile("s_waitcnt lgkmcnt(0)" ::: "memory"); SBAR();                 \
        o[d0] = __builtin_amdgcn_mfma_f32_32x32x16_bf16(pa0, (bf16x8){l0[0], l0[1], l0[2], l0[3], h0[0], h0[1], h0[2], h0[3]}, o[d0], 0, 0, 0);   \
        o[d0] = __builtin_amdgcn_mfma_f32_32x32x16_bf16(pa1, (bf16x8){l1[0], l1[1], l1[2], l1[3], h1[0], h1[1], h1[2], h1[3]}, o[d0], 0, 0, 0);   \
        o[d0] = __builtin_amdgcn_mfma_f32_32x32x16_bf16(pa2, (bf16x8){l2[0], l2[1], l2[2], l2[3], h2[0], h2[1], h2[2], h2[3]}, o[d0], 0, 0, 0);   \
        o[d0] = __builtin_amdgcn_mfma_f32_32x32x16_bf16(pa3, (bf16x8){l3[0], l3[1], l3[2], l3[3], h3[0], h3[1], h3[2], h3[3]}, o[d0], 0, 0, 0); } while (0)
    PV_D0(0); PV_D0(1); PV_D0(2); PV_D0(3);
#undef PV_D0
#undef TRRD
}

template <class TIn, class TOut> struct BlockRef { const TIn* Q; const TIn* K; const TIn* V; TOut* O; int P0; };
template <class TIn> struct Seam {
    bf16x8 qr[8];
    bf16x8 st_v0, st_v1, st_k0, st_k1; f32x4 sf0, sf1, sf2, sf3;
    f32x4 tq[16];
};
__device__ __forceinline__ int swa_jlo(int P0, int W) { const int lowk = P0 - W + 1; return lowk > 0 ? lowk / KVBLK : 0; }
#define ROW(p, k0, rr) ((p) + (size_t)((k0) + (rr)) * PITCH + sc)
#define VMW() asm volatile("s_waitcnt vmcnt(0)" ::: "memory")
#define VMWN(n) asm volatile("s_waitcnt vmcnt(%0)" :: "i"(n) : "memory")
#define SLOAD_H(Kp, Vp, k0) do { S.st_v0 = load8<TIn>(ROW(Vp, k0, sr)); S.st_v1 = load8<TIn>(ROW(Vp, k0, 32 + sr));              \
                         S.st_k0 = load8<TIn>(ROW(Kp, k0, sr)); S.st_k1 = load8<TIn>(ROW(Kp, k0, 32 + sr)); } while (0)
#define SWRITE_HK(bf) do { *(bf16x8*)(K_lds + (bf) * SHM_K + kws) = S.st_k0; *(bf16x8*)(K_lds + (bf) * SHM_K + kws + 32 * 256) = S.st_k1; } while (0)
#define SWRITE_HV(bf) do { *(bf16x8*)(V_lds + (bf) * SHM_V + vst0) = S.st_v0; *(bf16x8*)(V_lds + (bf) * SHM_V + vst1) = S.st_v1; } while (0)
#define SWRITE_H(bf) do { SWRITE_HV(bf); SWRITE_HK(bf); } while (0)
#define SLOAD_F(p, k0) do { S.sf0 = *(const f32x4*)ROW(p, k0, sr); S.sf1 = *(const f32x4*)(ROW(p, k0, sr) + 4);                \
                            S.sf2 = *(const f32x4*)ROW(p, k0, 32 + sr); S.sf3 = *(const f32x4*)(ROW(p, k0, 32 + sr) + 4); } while (0)
#define SWRITE_KF(bf) do { *(bf16x8*)(K_lds + (bf) * SHM_K + kws) = pack8(S.sf0, S.sf1); *(bf16x8*)(K_lds + (bf) * SHM_K + kws + 32 * 256) = pack8(S.sf2, S.sf3); } while (0)
#define SWRITE_VF(bf) do { *(bf16x8*)(V_lds + (bf) * SHM_V + vst0) = pack8(S.sf0, S.sf1); *(bf16x8*)(V_lds + (bf) * SHM_V + vst1) = pack8(S.sf2, S.sf3); } while (0)
template <class TIn, class TOut>
__device__ __forceinline__ void causal_swa_prime(const BlockRef<TIn, TOut>& cur, int W, char* lds, Seam<TIn>& S) {
    constexpr bool F32 = same_t<TIn, float>::v;
    const int tid = threadIdx.x, wid = __builtin_amdgcn_readfirstlane(tid >> 6), lane = tid & 63, r32 = lane & 31, hi = lane >> 5;
    const int sr = tid >> 4, sc = (tid & 15) * 8, kws = KSWZ(sr, sc * 2); char* K_lds = lds + 2 * SHM_V;
    const int kb0 = swa_jlo(cur.P0, W) * KVBLK;
    for (int d0 = 0; d0 < 8; ++d0) S.qr[d0] = load8<TIn>(cur.Q + (size_t)(wid * QBLK + r32) * PITCH + d0 * 16 + hi * 8);
    if constexpr (F32) { SLOAD_F((const float*)cur.K, kb0); VMW(); SWRITE_KF(0); SBAR(); SLOAD_F((const float*)cur.V, kb0); }
    else { SLOAD_H(cur.K, cur.V, kb0); VMW(); SWRITE_HK(0); }
    if (MK_NQR < 8) { char* Qw = lds + Q_LDS_OFF + wid * 8192; do { _Pragma("unroll") for (int d0_ = 0; d0_ < 8; ++d0_) *(bf16x8*)(Qw + KSWZ(r32, (d0_ * 16 + hi * 8) * 2)) = S.qr[d0_]; } while (0); }
    __syncthreads();
}
__device__ __forceinline__ unsigned moba_gate2(const bf16x8* qr, int P0, char* lds, const float* ksum, const float* lutg, bool newlut) {
    int tid_ = threadIdx.x; asm volatile("" : "+v"(tid_)); const int tid = tid_;
    char* kt = lds + 2 * SHM_V + SHM_K;
    {   const int j = tid >> 5, d4 = (tid & 31) * 4;
        const f32x4 s0 = *(const f32x4*)(ksum + (size_t)(2 * j) * 1024 + d4), s1 = *(const f32x4*)(ksum + (size_t)(2 * j + 1) * 1024 + d4);
        const f32x4 x = (s0 + s1) * (1.0f / 256.0f);
        const unsigned h0 = cvtpk(x[0], x[1]), h1 = cvtpk(x[2], x[3]);
        const unsigned l0 = cvtpk(x[0] - bf_lo(h0), x[1] - bf_hi(h0)), l1 = cvtpk(x[2] - bf_lo(h1), x[3] - bf_hi(h1));
        *(u32x2*)(kt + KSWZ(j, d4 * 2)) = (u32x2){h0, h1}; *(u32x2*)(kt + KSWZ(16 + j, d4 * 2)) = (u32x2){l0, l1};
        if (newlut) { float* lutl = (float*)(lds + LUT_LDS_OFF);
            for (int i = tid; i < LUTN; i += NW * 64) lutl[i] = lutg[i] * (1.0f / SCALE); }
    }
    __syncthreads();
    const int lane = tid & 63, r32 = lane & 31, hi = lane >> 5, qbI = P0 >> 8;
    f32x16 p = {};
#pragma unroll
    for (int d0 = 0; d0 < 8; ++d0) { const bf16x8 b0 = *reinterpret_cast<const bf16x8*>(kt + KSWZ(r32, ((d0 & 3) * 16 + hi * 8) * 2) + (d0 >> 2) * 128);
        p = __builtin_amdgcn_mfma_f32_32x32x16_bf16(b0, qr[d0], p, 0, 0, 0); }
    float bv0 = -__builtin_inff(), bv1 = bv0, bv2 = bv0; int bi0 = 0, bi1 = 0, bi2 = 0;
#define INS3(xv, xi) do { float x_ = (xv); int i_ = (xi); bool g_; float tv_; int ti_; \
        g_ = (x_ > bv0) || (x_ == bv0 && i_ < bi0); tv_ = g_ ? bv0 : x_; ti_ = g_ ? bi0 : i_; bv0 = g_ ? x_ : bv0; bi0 = g_ ? i_ : bi0; x_ = tv_; i_ = ti_; \
        g_ = (x_ > bv1) || (x_ == bv1 && i_ < bi1); tv_ = g_ ? bv1 : x_; ti_ = g_ ? bi1 : i_; bv1 = g_ ? x_ : bv1; bi1 = g_ ? i_ : bi1; x_ = tv_; i_ = ti_; \
        g_ = (x_ > bv2) || (x_ == bv2 && i_ < bi2); bv2 = g_ ? x_ : bv2; bi2 = g_ ? i_ : bi2; } while (0)
#pragma unroll
    for (int jj = 0; jj < 8; ++jj) { const int jb = (jj & 3) + 8 * (jj >> 2) + 4 * hi; INS3(jb < qbI ? p[jj] + p[jj + 8] : -__builtin_inff(), jb); }
    const float ov0 = __shfl_xor(bv0, 32), ov1 = __shfl_xor(bv1, 32), ov2 = __shfl_xor(bv2, 32); const int oi0 = __shfl_xor(bi0, 32), oi1 = __shfl_xor(bi1, 32), oi2 = __shfl_xor(bi2, 32);
    INS3(ov0, oi0); INS3(ov1, oi1); INS3(ov2, oi2);
#undef INS3
    unsigned selmask = 0;
    if (bv0 > -__builtin_inff()) selmask |= 1u << bi0; if (bv1 > -__builtin_inff()) selmask |= 1u << bi1; if (bv2 > -__builtin_inff()) selmask |= 1u << bi2;
    __syncthreads();
    return selmask;
}
template <class TIn, class TOut, int VAR = 0>
__device__ __forceinline__ void causal_swa_block(const BlockRef<TIn, TOut>& cur, const BlockRef<TIn, TOut>& nxt, int skv, int W, char* lds, Seam<TIn>& S, float farb, unsigned selmask_in) {
    constexpr bool F32 = same_t<TIn, float>::v;
    int tid_ = threadIdx.x; asm volatile("" : "+v"(tid_));
    const int tid = tid_, wid = __builtin_amdgcn_readfirstlane(tid >> 6), lane = tid & 63, r32 = lane & 31, hi = lane >> 5;
    const int j_lo = swa_jlo(cur.P0, W);
    int j_hi = (cur.P0 + QB - 1) / KVBLK + 1; if (j_hi > skv / KVBLK) j_hi = skv / KVBLK;
    const int NT = j_hi - j_lo;
    const int kbn = swa_jlo(nxt.P0, W) * KVBLK;
    const int qlo = cur.P0 + wid * QBLK, qm = qlo + r32 - 4 * hi;
    char* V_lds = lds; char* K_lds = lds + 2 * SHM_V; char* Qw = lds + Q_LDS_OFF + wid * 8192;
    float* ws = (float*)(lds + 2 * SHM_V + 2 * SHM_K) + wid * 64; float* li_l = ws, * al_l = ws + 32;
    float m_reg = -1e30f, l_reg = 0; f32x16 o[4] = {};
    const float* lutp = (const float*)(lds + LUT_LDS_OFF) + (qm + LUT_OFF - 59);
    const int sr = tid >> 4, sc = (tid & 15) * 8, vst0 = v_st(sr, sc), vst1 = v_st(32 + sr, sc), kws = KSWZ(sr, sc * 2);
    const int vb0 = (int)(uintptr_t)V_lds + v_rd_base(lane);
    const TIn* Kh = cur.K; const TIn* Vh = cur.V;
#define RESC(a) do { if (__any((a) < 1.f)) { if (hi == 0) al_l[r32] = (a); asm volatile("s_waitcnt lgkmcnt(0)" ::: "memory");              \
                     for (int d_ = 0; d_ < 4; ++d_) for (int r = 0; r < 16; ++r) o[d_][r] *= al_l[crow(r, hi)]; } } while (0)
#define KBASE(t) ((j_lo + (t)) * KVBLK)
#define ACT(t) (KBASE(t) <= qlo + QBLK - 1 && KBASE(t) + KVBLK - 1 >= qlo - W + 1)
#define BIAS_TILE(P0_, P1_, kb_) bias_tile(P0_, P1_, lutp - (kb_))
#define MASKT(P0_, P1_, t, cst_) do { const int kb_ = KBASE(t), jb_ = kb_ >> 8; float c_ = 0.f; if ((VAR != 1 && VAR != 3) && jb_ < (cur.P0 >> 8)) c_ = ((selmask >> jb_) & 1u) ? 0.f : -__builtin_inff(); \
        if ((VAR != 1 && VAR != 3) && qlo - kb_ - 63 >= 790) c_ += farb; else { if ((VAR != 1 && VAR != 3)) BIAS_TILE(P0_, P1_, kb_); if (kb_ + KVBLK - 1 > qlo) mask_tile(P0_, P1_, qm - kb_, (unsigned)W); } cst_ = c_; } while (0)
    constexpr int NQL = F32 ? 16 : 8;
    constexpr bool SK = WSKIP && !F32;
#define SEAM_K0() do { VMWN(NQL); if constexpr (F32) { SWRITE_KF(0); SBAR(); SLOAD_F((const float*)nxt.V, kbn); } else { SWRITE_HK(0); } SBAR(); } while (0)
    f32x16 pA0, pA1, pB0, pB1; float mnA, mnB, alA, alB, cA, cB; bf16x8 pa0, pa1, pa2, pa3;
    const unsigned selmask = selmask_in;
    if constexpr (F32) { VMW(); SWRITE_VF(0); SBAR(); } else { SWRITE_HV(0); SBAR(); }
    if (NT > 1) { if constexpr (F32) SLOAD_F((const float*)Kh, KBASE(1)); else SLOAD_H(Kh, Vh, KBASE(1)); }
    SBAR(); qkt<0, SK, (VAR == 3 ? 8 : MK_NQR)>(pA0, pA1, K_lds, r32, hi, Qw, ACT(0), S.qr);
    if constexpr (F32) { if (NT > 1) { VMW(); SWRITE_KF(1); SBAR(); SLOAD_F((const float*)Vh, KBASE(1)); } }
    MASKT(pA0, pA1, 0, cA); partialSM(pA0, pA1, cA, m_reg, mnA, alA);
    if (NT > 1) { VMW(); if constexpr (F32) { SWRITE_VF(1); SBAR(); if (NT > 2) SLOAD_F((const float*)Kh, KBASE(2)); } else SWRITE_H(1); }
    __syncthreads();
#define HALF_STEP(PX0, PX1, cX, mnX, alX, PY0, PY1, alY, t, KB, VB, SB) do {                                                      \
        SBAR(); qkt<KB, SK, (VAR == 3 ? 8 : MK_NQR)>(PX0, PX1, K_lds, r32, hi, Qw, ACT(t), S.qr);                                             \
        finishSM(PY0, PY1, alY, l_reg, pa0, pa1, pa2, pa3); SBAR();                                                           \
        if ((t) + 1 < NT) { if constexpr (F32) { VMW(); SWRITE_KF(SB); SBAR(); SLOAD_F((const float*)Vh, KBASE((t) + 1)); }  \
                            else { SLOAD_H(Kh, Vh, KBASE((t) + 1)); } SBAR(); }                                               \
        pv_tile<VB, SK>(o, vb0, pa0, pa1, pa2, pa3, ACT((t) - 1)); MASKT(PX0, PX1, (t), cX); partialSM(PX0, PX1, cX, m_reg, mnX, alX);                                        \
        __syncthreads();                                                                                                      \
        if ((t) + 1 < NT) { VMW(); if constexpr (F32) { SWRITE_VF(SB); SBAR(); if ((t) + 2 < NT) SLOAD_F((const float*)Kh, KBASE((t) + 2)); } \
                            else { SWRITE_H(SB); } }                                                                          \
        RESC(alX); __syncthreads(); } while (0)
    for (int t = 1; t + 1 < NT; t += 2) {
        HALF_STEP(pB0, pB1, cB, mnB, alB, pA0, pA1, alA, t, 1, 0, 0);
        HALF_STEP(pA0, pA1, cA, mnA, alA, pB0, pB1, alB, t + 1, 0, 1, 1);
    }
    const bool even = (NT & 1) == 0;
    if (even) { SBAR(); qkt<1, SK, (VAR == 3 ? 8 : MK_NQR)>(pB0, pB1, K_lds, r32, hi, Qw, ACT(NT - 1), S.qr); SBAR(); }
#define QROW(e) (nxt.Q + (size_t)(wid * QBLK + r32) * D + ((e) >> 1) * 16 + hi * 8 + ((e) & 1) * 4)
    if constexpr (F32) { SLOAD_F((const float*)nxt.K, kbn); SBAR();
#pragma unroll
        for (int e = 0; e < 8; ++e) S.tq[e] = *(const f32x4*)QROW(e); }
    else { SLOAD_H(nxt.K, nxt.V, kbn); SBAR();
#pragma unroll
        for (int d0 = 0; d0 < 8; ++d0) S.qr[d0] = load8<TIn>(nxt.Q + (size_t)(wid * QBLK + r32) * PITCH + d0 * 16 + hi * 8); }
    SBAR();
    finishSM(pA0, pA1, alA, l_reg, pa0, pa1, pa2, pa3); SBAR();
    if constexpr (F32) {
#pragma unroll
        for (int e = 8; e < 16; ++e) S.tq[e] = *(const f32x4*)QROW(e); SBAR(); }
#undef QROW
    pv_tile<0, SK>(o, vb0, pa0, pa1, pa2, pa3, ACT(even ? NT - 2 : NT - 1));
    if (even) { MASKT(pB0, pB1, NT - 1, cB); partialSM(pB0, pB1, cB, m_reg, mnB, alB); __syncthreads(); RESC(alB);
        finishSM(pB0, pB1, alB, l_reg, pa0, pa1, pa2, pa3); SBAR(); pv_tile<1, SK>(o, vb0, pa0, pa1, pa2, pa3, ACT(NT - 1)); }
    SBAR(); SEAM_K0(); VMW(); if (VAR != 3 && MK_NQR < 8) do { _Pragma("unroll") for (int d0_ = 0; d0_ < 8; ++d0_) *(bf16x8*)(Qw + KSWZ(r32, (d0_ * 16 + hi * 8) * 2)) = S.qr[d0_]; } while (0); SBAR();
    if (hi == 0) li_l[r32] = l_reg; asm volatile("s_waitcnt lgkmcnt(0)" ::: "memory");
    float rli[16];
#pragma unroll
    for (int r = 0; r < 16; ++r) rli[r] = __builtin_amdgcn_rcpf(li_l[crow(r, hi)]);
    TOut* Ow = cur.O + (size_t)(wid * QBLK) * PITCH;
#pragma unroll
    for (int r = 0; r < 16; ++r) { const int orow = crow(r, hi);
#pragma unroll
        for (int d0 = 0; d0 < 4; ++d0) { const float v = o[d0][r] * rli[r];
            if constexpr (same_t<TOut, float>::v) { Ow[(size_t)orow * D + d0 * 32 + r32] = v; }
            else { const float vn = __shfl_xor(v, 1);
                   if ((r32 & 1) == 0) *(unsigned*)(Ow + (size_t)orow * PITCH + d0 * 32 + r32) = cvtpk(v, vn); } } }
    if constexpr (F32) {
#pragma unroll
        for (int d0 = 0; d0 < 8; ++d0) S.qr[d0] = pack8(S.tq[2 * d0], S.tq[2 * d0 + 1]); }
    __syncthreads();
#undef RESC
#undef KBASE
#undef ACT
#undef MASKT
#undef BIAS_TILE
#undef SEAM_K0
#undef HALF_STEP
}
#undef ROW
#undef VMW
#undef VMWN
#undef SLOAD_H
#undef SWRITE_HK
#undef SWRITE_HV
#undef SWRITE_H
#undef SLOAD_F
#undef SWRITE_KF
#undef SWRITE_VF

}

template <int VAR = 0>
__device__ __forceinline__ void phase3_fast(ArgsP a, LAS unsigned char* lds_las, int tid, int lane, int wave, bool dummy_out = false) {
    unsigned char* ws = a->ws;
    bf16_t* QO = (bf16_t*)(ws + WS_R3); const bf16_t* Kt = (const bf16_t*)(ws + WS_R4); const bf16_t* Vt = (const bf16_t*)(ws + WS_R5);
    const float* ksum = (const float*)(ws + WS_KSUM); const float* lut = (const float*)(ws + WS_LUT); const float* rb = a->in[13];
    char* lds = (char*)lds_las;
    static_assert(attn::LDS_NEED <= LDS_BYTES, "attention LDS map");
    const int G = gridDim.x, bx = blockIdx.x, vcu = (G % 8 == 0) ? (bx % 8) * (G / 8) + bx / 8 : bx;
    constexpr int NITEM = NBATCH * NHEAD * 8;
    typedef attn::BlockRef<bf16_t, bf16_t> BR;
    auto ref = [&](int item, int pass) { const int bh = item >> 3, x = item & 7, b = bh >> 3, h = bh & 7, qb = pass ? 15 - x : x;
        BR r; const size_t base = (size_t)b * SEQ * 1024 + h * 128;
        r.Q = QO + base + (size_t)qb * 256 * 1024; r.O = dummy_out ? (bf16_t*)(ws + WS_END) + h * 128 : QO + base + (size_t)qb * 256 * 1024; r.K = Kt + base; r.V = Vt + base; r.P0 = qb * 256; return r; };
    int item = vcu * 2; if (item >= NITEM) return;
    int pass = 0; const int istride = G * 2;
    BR cur = ref(item, 0);
    attn::Seam<bf16_t> S; int hprev = -1;
    attn::causal_swa_prime<bf16_t, bf16_t>(cur, 1 << 30, lds, S);
    for (;;) {
        int itn = item, pn = pass + 1; bool last = false;
        if (pass == 1) { pn = 0; itn = item + 1; if ((itn & 1) == 0) itn = item - 1 + istride; if (itn >= NITEM) { last = true; itn = item; pn = pass; } }
        const BR nxt = last ? cur : ref(itn, pn);
        const int bh = item >> 3, b = bh >> 3, h = bh & 7;
        unsigned selmask = 0xffffu;
        if (VAR == 0) { selmask = attn::moba_gate2(S.qr, cur.P0, lds, ksum + (size_t)b * 32 * 1024 + h * 128, lut + h * LUTN, h != hprev); hprev = h; }
        attn::causal_swa_block<bf16_t, bf16_t, VAR>(cur, nxt, SEQ, 1 << 30, lds, S, rb[31 * NHEAD + h] * (1.0f / attn::SCALE), selmask);
        if (last) break;
        cur = nxt; item = itn; pass = pn;
    }
}
__device__ __forceinline__ void phase5b(ArgsP a, int lane, int wave) {
    unsigned char* ws = a->ws; const bf16_t* hp = (const bf16_t*)(ws + WS_R0); bf16_t* hb = (bf16_t*)(ws + WS_R3); unsigned* h8 = (unsigned*)(ws + WS_H8); const float* g = a->in[11]; const float* bb = a->in[12];
    const int gw = blockIdx.x * NWAVES + wave, NGW = gridDim.x * NWAVES;
    for (int m = gw; m < T_TOK; m += NGW) {
        f32x4 v[4]; float s = 0.f;
#pragma unroll
        for (int j = 0; j < 4; ++j) { const u32x2 w = *((const u32x2*)(hp + (size_t)m * 1024) + lane + 64 * j); v[j] = (f32x4){bf_lo(w.x), bf_hi(w.x), bf_lo(w.y), bf_hi(w.y)}; s += (v[j][0] + v[j][1]) + (v[j][2] + v[j][3]); }
        const float mean = wave_sum(s) * (1.f / 1024.f); float s2 = 0.f;
#pragma unroll
        for (int j = 0; j < 4; ++j) { v[j] = v[j] - mean; s2 += (v[j][0] * v[j][0] + v[j][1] * v[j][1]) + (v[j][2] * v[j][2] + v[j][3] * v[j][3]); }
        const float rstd = 1.f / sqrtf(wave_sum(s2) * (1.f / 1024.f) + LN_EPS);
        u32x2* o8 = (u32x2*)(hb + (size_t)m * 1024) + lane;
#pragma unroll
        for (int j = 0; j < 4; ++j) { const f32x4 gg = *((const f32x4*)g + lane + 64 * j), b4 = *((const f32x4*)bb + lane + 64 * j); const f32x4 y = v[j] * rstd * gg + b4;
            u32x2 w; w.x = pkbf(y[0], y[1]); w.y = pkbf(y[2], y[3]); o8[64 * j] = w;
            h8[((size_t)(2 * j + (lane >> 5)) * T_TOK + m) * 32 + (lane & 31)] = pack_i8x4(y * PEER_H_SCALE); }
    }
}
__device__ __forceinline__ void phase10(ArgsP a, int lane, int wave) {
    unsigned char* ws = a->ws; const bf16_t* hb = (const bf16_t*)(ws + WS_R3); const bf16_t* eb = (const bf16_t*)(ws + WS_R2); const bf16_t* f = (const bf16_t*)(ws + WS_R4);
    const float* g = a->in[21]; const float* bb = a->in[22]; float* out = a->out;
    const int gw = blockIdx.x * NWAVES + wave, NGW = gridDim.x * NWAVES;
    for (int m = gw; m < T_TOK; m += NGW) {
        f32x4 v[4]; float s = 0.f;
#pragma unroll
        for (int j = 0; j < 4; ++j) { const u32x2 hw = *((const u32x2*)(hb + (size_t)m * 1024) + lane + 64 * j), ew = *((const u32x2*)(eb + (size_t)m * 1024) + lane + 64 * j);
            const u32x2 fw = *((const u32x2*)(f + (size_t)m * 1024) + lane + 64 * j);
            v[j][0] = ALPHA * bf_lo(hw.x) + bf_lo(fw.x) + bf_lo(ew.x); v[j][1] = ALPHA * bf_hi(hw.x) + bf_hi(fw.x) + bf_hi(ew.x);
            v[j][2] = ALPHA * bf_lo(hw.y) + bf_lo(fw.y) + bf_lo(ew.y); v[j][3] = ALPHA * bf_hi(hw.y) + bf_hi(fw.y) + bf_hi(ew.y);
            s += (v[j][0] + v[j][1]) + (v[j][2] + v[j][3]); }
        const float mean = wave_sum(s) * (1.f / 1024.f); float s2 = 0.f;
#pragma unroll
        for (int j = 0; j < 4; ++j) { v[j] = v[j] - mean; s2 += (v[j][0] * v[j][0] + v[j][1] * v[j][1]) + (v[j][2] * v[j][2] + v[j][3] * v[j][3]); }
        const float rstd = 1.f / sqrtf(wave_sum(s2) * (1.f / 1024.f) + LN_EPS);
        f32x4* o = (f32x4*)(out + (size_t)m * 1024) + lane;
#pragma unroll
        for (int j = 0; j < 4; ++j) { const f32x4 gg = *((const f32x4*)g + lane + 64 * j), b4 = *((const f32x4*)bb + lane + 64 * j); o[64 * j] = v[j] * rstd * gg + b4; }
    }
}

__device__ __forceinline__ int tk_sortable(float v) { const int b = __float_as_int(v); return b ^ ((b >> 31) & 0x7fffffff); }
__device__ __forceinline__ float tk_value(int k, int mask) { const int s = k & ~mask; return __int_as_float(s ^ ((s >> 31) & 0x7fffffff)); }
#define TK_INS(K, key) do { int x_ = (key); _Pragma("unroll") for (int q_ = 0; q_ < 16; ++q_) { const int hi_ = max(K[q_], x_); x_ = min(K[q_], x_); K[q_] = hi_; } } while (0)
__device__ __forceinline__ void tk_sort16(int (&v)[16]) {
#define TK_CE(a_, b_) do { const int hi_ = max(v[a_], v[b_]), lo_ = min(v[a_], v[b_]); v[a_] = hi_; v[b_] = lo_; } while (0)
    TK_CE(0, 13); TK_CE(1, 12); TK_CE(2, 15); TK_CE(3, 14); TK_CE(4, 8); TK_CE(5, 6); TK_CE(7, 11); TK_CE(9, 10);
    TK_CE(0, 5); TK_CE(1, 7); TK_CE(2, 9); TK_CE(3, 4); TK_CE(6, 13); TK_CE(8, 14); TK_CE(10, 15); TK_CE(11, 12);
    TK_CE(0, 1); TK_CE(2, 3); TK_CE(4, 5); TK_CE(6, 8); TK_CE(7, 9); TK_CE(10, 11); TK_CE(12, 13); TK_CE(14, 15);
    TK_CE(0, 2); TK_CE(1, 3); TK_CE(4, 10); TK_CE(5, 11); TK_CE(6, 7); TK_CE(8, 9); TK_CE(12, 14); TK_CE(13, 15);
    TK_CE(1, 2); TK_CE(3, 12); TK_CE(4, 6); TK_CE(5, 7); TK_CE(8, 10); TK_CE(9, 11); TK_CE(13, 14);
    TK_CE(1, 4); TK_CE(2, 6); TK_CE(5, 8); TK_CE(7, 10); TK_CE(9, 13); TK_CE(11, 14);
    TK_CE(2, 4); TK_CE(3, 6); TK_CE(9, 12); TK_CE(11, 13);
    TK_CE(3, 5); TK_CE(6, 8); TK_CE(7, 9); TK_CE(10, 12);
    TK_CE(3, 4); TK_CE(5, 6); TK_CE(7, 8); TK_CE(9, 10); TK_CE(11, 12);
    TK_CE(6, 7); TK_CE(8, 9);
#undef TK_CE
}
__device__ __forceinline__ void tk_merge16(int (&K)[16], int (&B)[16]) {
#pragma unroll
    for (int i = 0; i < 16; ++i) K[i] = max(K[i], B[15 - i]);
#pragma unroll
    for (int j = 8; j > 0; j >>= 1)
#pragma unroll
        for (int i = 0; i < 16; ++i) { const int l = i ^ j; if (l > i) { const int hi = max(K[i], K[l]), lo = min(K[i], K[l]); K[i] = hi; K[l] = lo; } }
}
__device__ __forceinline__ float h16_lo(unsigned x) { return (float)__builtin_bit_cast(_Float16, (unsigned short)(x & 0xffffu)); }
__device__ __forceinline__ float h16_hi(unsigned x) { return (float)__builtin_bit_cast(_Float16, (unsigned short)(x >> 16)); }
typedef short s16x2_t __attribute__((ext_vector_type(2)));
__device__ __forceinline__ unsigned tk_sortable16x2(unsigned x) { const s16x2_t sg = __builtin_bit_cast(s16x2_t, x) >> (short)15; return x ^ (__builtin_bit_cast(unsigned, sg) & 0x7fff7fffu); }
__device__ __forceinline__ float tk_value16(int k) { const int s = k >> 16; const int h = s ^ ((s >> 15) & 0x7fff); return (float)__builtin_bit_cast(_Float16, (unsigned short)(h & 0xffff)); }
__device__ __forceinline__ void phase7(ArgsP a, LAS unsigned char* lds, int tid, int lane, int wave) {
    unsigned char* ws = a->ws; const float* sA = (const float*)(ws + WS_R0); const float* sB = (const float*)(ws + WS_R4);
    int* idx = (int*)a->out; float* gates = a->out + (size_t)T_TOK * NPAIR;
    LAS float* tile = (LAS float*)(lds + wave * 8704); LAS unsigned* tileu = (LAS unsigned*)tile;
    const int gw = blockIdx.x * NWAVES + wave, NGW = gridDim.x * NWAVES;
    const int NGRP = (T_TOK * NHEAD) / 64;
#define P7_SRC(g_) ((const _Float16*)((((g_) * 64 / (T_TOK * 4)) != 0) ? sB : sA) + (size_t)((g_) * 64 % (T_TOK * 4)) * 256)
#define P7_LOAD(PRE, s_, c_) do { _Pragma("unroll") for (int it = 0; it < 8; ++it) PRE[it] = *(const u32x2*)((s_) + (size_t)(it * 8 + (lane >> 3)) * 256 + (c_) * 32 + (lane & 7) * 4); } while (0)
#define P7_H(x_, k_) ((k_) ? h16_hi(x_) : h16_lo(x_))
#define P7_STEP(PRE, c_) do { \
            _Pragma("unroll") for (int it = 0; it < 8; ++it) { LAS unsigned* d = tileu + (it * 8 + (lane >> 3)) * 17 + (lane & 7) * 2; d[0] = PRE[it].x; d[1] = PRE[it].y; }        \
            if ((c_) + 2 < 8) P7_LOAD(PRE, src, (c_) + 2); else if (has_next) P7_LOAD(PRE, nsrc, (c_) + 2 - 8); \
            asm volatile("s_waitcnt lgkmcnt(0)" ::: "memory"); \
            const int nb = 127 - ((c_) & 3) * 32; \
            _Pragma("unroll") for (int hb = 0; hb < 2; ++hb) { int bt[16]; \
                _Pragma("unroll") for (int j2 = 0; j2 < 8; ++j2) { const unsigned s_ = tk_sortable16x2(tileu[lane * 17 + hb * 8 + j2]); \
                    bt[2 * j2] = (int)((s_ << 16) | (unsigned)(nb - hb * 16 - 2 * j2)); bt[2 * j2 + 1] = (int)((s_ & 0xffff0000u) | (unsigned)(nb - hb * 16 - 2 * j2 - 1)); } \
                tk_sort16(bt); \
                if (hb == 0 && ((c_) & 3) == 0) { if ((c_) < 4) { _Pragma("unroll") for (int j = 0; j < 16; ++j) ka[j] = bt[j]; } else { _Pragma("unroll") for (int j = 0; j < 16; ++j) kb[j] = bt[j]; } }        \
                else if ((c_) < 4) tk_merge16(ka, bt); else tk_merge16(kb, bt); } \
            asm volatile("s_waitcnt lgkmcnt(0)" ::: "memory"); } while (0)
    if (gw >= NGRP) return;
    const _Float16* src = P7_SRC(gw);
    u32x2 preA[8], preB[8];
    P7_LOAD(preA, src, 0); P7_LOAD(preB, src, 1);
    for (int grp = gw; grp < NGRP; grp += NGW) {
        const int P0 = grp * 64, half = P0 / (T_TOK * 4), i0 = P0 % (T_TOK * 4);
        const bool has_next = grp + NGW < NGRP; const _Float16* nsrc = has_next ? P7_SRC(grp + NGW) : src;
        int ka[16], kb[16];
#pragma unroll
        for (int q = 0; q < 16; ++q) { ka[q] = (int)0x80000000; kb[q] = (int)0x80000000; }
        for (int c = 0; c < 8; c += 2) {
            P7_STEP(preA, c);
            P7_STEP(preB, c + 1);
        }
        src = nsrc;
        LAS unsigned char* tab = (LAS unsigned char*)tile + lane * 32;
#pragma unroll
        for (int q = 0; q < 16; ++q) { tab[q] = (unsigned char)(127 - (ka[q] & 127)); tab[16 + q] = (unsigned char)(127 - (kb[q] & 127)); }
        float va[16], vb[16];
#pragma unroll
        for (int q = 0; q < 16; ++q) { va[q] = tk_value16(ka[q]); vb[q] = tk_value16(kb[q]); }
        int kr[16];
#pragma unroll
        for (int q = 0; q < 16; ++q) kr[q] = (int)0x80000000;
        {
            int cand[64]; int nc = 0;
#pragma unroll
            for (int i = 0; i < 16; ++i)
#pragma unroll
                for (int j = 0; j < 16; ++j) if ((i + 1) * (j + 1) <= 16) { cand[nc] = (tk_sortable(va[i] + vb[j]) & ~255) | (255 - (i * 16 + j)); ++nc; }
#pragma unroll
            for (int q = 50; q < 64; ++q) cand[q] = (int)0x80000000;
#pragma unroll
            for (int bq = 0; bq < 4; ++bq) { int bt[16];
#pragma unroll
                for (int q = 0; q < 16; ++q) bt[q] = cand[bq * 16 + q];
                tk_sort16(bt); if (bq == 0) { _Pragma("unroll") for (int q = 0; q < 16; ++q) kr[q] = bt[q]; } else tk_merge16(kr, bt); } }
        asm volatile("s_waitcnt lgkmcnt(0)" ::: "memory");
        float ev[16]; int ex[16]; float sum = 0.f; const float v0 = tk_value(kr[0], 255);
#pragma unroll
        for (int q = 0; q < 16; ++q) { ev[q] = __expf(tk_value(kr[q], 255) - v0); sum += ev[q]; const int code = 255 - (kr[q] & 255); ex[q] = (int)tab[code >> 4] * 128 + (int)tab[16 + (code & 15)]; }
        const float inv = 1.0f / sum;
        const int i = i0 + lane, t = i >> 2, hh = half * 4 + (i & 3);
        int* ip = idx + (size_t)t * NPAIR + hh * 16; float* gp = gates + (size_t)t * NPAIR + hh * 16;
#pragma unroll
        for (int q = 0; q < 4; ++q) { *(int4*)(ip + 4 * q) = make_int4(ex[4 * q], ex[4 * q + 1], ex[4 * q + 2], ex[4 * q + 3]);
            *(f32x4*)(gp + 4 * q) = (f32x4){ev[4 * q] * inv, ev[4 * q + 1] * inv, ev[4 * q + 2] * inv, ev[4 * q + 3] * inv}; }
        asm volatile("s_waitcnt lgkmcnt(0)" ::: "memory");
    }
#undef P7_SRC
#undef P7_H
#undef P7_LOAD
#undef P7_STEP
}

__device__ __forceinline__ float fdot2bf(unsigned a, unsigned b, float c) { return __builtin_amdgcn_fdot2_f32_bf16(__builtin_bit_cast(bf16x2_t, a), __builtin_bit_cast(bf16x2_t, b), c, false); }
__device__ __forceinline__ float dot8bf(const u32x4 h, const u32x4 w) { return fdot2bf(h.w, w.w, fdot2bf(h.z, w.z, fdot2bf(h.y, w.y, fdot2bf(h.x, w.x, 0.f)))); }
template <int M> __device__ __forceinline__ float xshf(float v) {
    if (M == 1) return __int_as_float(__builtin_amdgcn_mov_dpp(__float_as_int(v), 0xB1, 0xF, 0xF, true));
    if (M == 2) return __int_as_float(__builtin_amdgcn_mov_dpp(__float_as_int(v), 0x4E, 0xF, 0xF, true));
    return __int_as_float(__builtin_amdgcn_ds_swizzle(__float_as_int(v), (M << 10) | 0x1F));
}
__device__ __forceinline__ float tred16(float (&v)[16], int sub) {
#pragma unroll
    for (int k = 0; k < 8; ++k) { const float s = (sub & 8) ? v[k] : v[k + 8], kp = (sub & 8) ? v[k + 8] : v[k]; v[k] = kp + xshf<8>(s); }
#pragma unroll
    for (int k = 0; k < 4; ++k) { const float s = (sub & 4) ? v[k] : v[k + 4], kp = (sub & 4) ? v[k + 4] : v[k]; v[k] = kp + xshf<4>(s); }
#pragma unroll
    for (int k = 0; k < 2; ++k) { const float s = (sub & 2) ? v[k] : v[k + 2], kp = (sub & 2) ? v[k + 2] : v[k]; v[k] = kp + xshf<2>(s); }
    { const float s = (sub & 1) ? v[0] : v[1], kp = (sub & 1) ? v[1] : v[0]; v[0] = kp + xshf<1>(s); }
    return v[0];
}
template <int M4, int M2, int M1> __device__ __forceinline__ void tred8x16(float (&v)[16], int lane) {
#pragma unroll
    for (int k = 0; k < 8; ++k) { const float s = (lane & M4) ? v[k] : v[k + 8], kp = (lane & M4) ? v[k + 8] : v[k]; v[k] = kp + (M4 == 32 ? __shfl_xor(s, 32) : xshf<(M4 & 31)>(s)); }
#pragma unroll
    for (int k = 0; k < 4; ++k) { const float s = (lane & M2) ? v[k] : v[k + 4], kp = (lane & M2) ? v[k + 4] : v[k]; v[k] = kp + (M2 == 32 ? __shfl_xor(s, 32) : xshf<(M2 & 31)>(s)); }
#pragma unroll
    for (int k = 0; k < 2; ++k) { const float s = (lane & M1) ? v[k] : v[k + 2], kp = (lane & M1) ? v[k + 2] : v[k]; v[k] = kp + (M1 == 32 ? __shfl_xor(s, 32) : xshf<(M1 & 31)>(s)); }
}
__device__ __forceinline__ void phase8(ArgsP a, LAS unsigned char* lds, int lane, int wave) {
    unsigned char* ws = a->ws; const unsigned char* h8 = ws + WS_H8; const unsigned char* PU = ws + WS_PU; float* part = (float*)(ws + WS_R0);
    const int* idx = (const int*)a->out;
    const int sub = lane & 7, grp = lane >> 3, tp = (lane & 7) * 16 + (lane >> 3);
    LAS int* ib = (LAS int*)(lds + wave * 1536);
#define P8_IDS(E, buf) do { _Pragma("unroll") for (int q_ = 0; q_ < 4; ++q_) { const i32x4 v_ = *(const LAS i32x4*)((buf) + grp * 16 + 4 * q_); E[4 * q_] = v_.x; E[4 * q_ + 1] = v_.y; E[4 * q_ + 2] = v_.z; E[4 * q_ + 3] = v_.w; } } while (0)
#define P8_GATHER(U, E) do { _Pragma("unroll") for (int j_ = 0; j_ < 16; ++j_) U[j_] = *(const u32x4*)(PUx + (size_t)E[j_] * 128); } while (0)
#define P8_DOT(D, U) do { _Pragma("unroll") for (int j_ = 0; j_ < 16; ++j_) D[j_] = (float)__builtin_amdgcn_sdot4((int)U[j_].w, (int)h8_.w, __builtin_amdgcn_sdot4((int)U[j_].z, (int)h8_.z, __builtin_amdgcn_sdot4((int)U[j_].y, (int)h8_.y, __builtin_amdgcn_sdot4((int)U[j_].x, (int)h8_.x, 0, false), false), false), false); } while (0)
#define P8_TOKEN(U, t_) do { const u32x4 h8_ = *(const u32x4*)(h8 + ((size_t)x * T_TOK + (t_)) * 128 + sub * 16); \
        float d[16]; P8_DOT(d, U); tred8x16<4, 2, 1>(d, lane); \
        float* pp_ = part + ((size_t)x * T_TOK + (t_)) * NPAIR + 16 * sub + grp; pp_[0] = d[0] * (1.0f / (PEER_U_SCALE * PEER_H_SCALE)); pp_[8] = d[1] * (1.0f / (PEER_U_SCALE * PEER_H_SCALE)); } while (0)
    LAS int* ibs[3] = {ib, ib + 128, ib + 256};
    for (int cell = blockIdx.x; cell < 256; cell += gridDim.x) {
        const int x = cell & 7, c = cell >> 3; const unsigned char* PUx = PU + (size_t)x * (16384 * 128) + sub * 16; const int tend = c * 1024 + 1024;
        int t = c * 1024 + wave;
        u32x4 uA[16], uB[16], uC[16]; int e[16]; int i0, i1;
#define P8_LDIDX(t_) do { const int tt_ = (t_) < tend ? (t_) : tend - 8; i0 = idx[(size_t)tt_ * NPAIR + lane]; i1 = idx[(size_t)tt_ * NPAIR + 64 + lane]; } while (0)
#define P8_PUT(buf) do { (buf)[tp] = i0; (buf)[tp + 8] = i1; } while (0)
        P8_LDIDX(t); P8_PUT(ibs[0]); P8_LDIDX(t + 8); P8_PUT(ibs[1]); P8_LDIDX(t + 16);
        P8_IDS(e, ibs[0]); P8_GATHER(uA, e); P8_IDS(e, ibs[1]); P8_GATHER(uB, e);
        for (int n = 0; n < 126; n += 3, t += 24) {
            P8_PUT(ibs[2]); P8_LDIDX(t + 24); P8_IDS(e, ibs[2]); P8_GATHER(uC, e); P8_TOKEN(uA, t);
            P8_PUT(ibs[0]); P8_LDIDX(t + 32); P8_IDS(e, ibs[0]); P8_GATHER(uA, e); P8_TOKEN(uB, t + 8);
            P8_PUT(ibs[1]); P8_LDIDX(t + 40); P8_IDS(e, ibs[1]); P8_GATHER(uB, e); P8_TOKEN(uC, t + 16);
        }
        P8_TOKEN(uA, t); P8_TOKEN(uB, t + 8);
#undef P8_LDIDX
#undef P8_PUT
    }
#undef P8_IDS
#undef P8_GATHER
#undef P8_DOT
#undef P8_TOKEN
}
__device__ __forceinline__ void phase9w(ArgsP a, int tid) {
    const float* part = (const float*)(a->ws + WS_R0); const float* gates = a->out + (size_t)T_TOK * NPAIR; float* wout = (float*)(a->ws + WS_W);
    const size_t n4 = (size_t)T_TOK * NPAIR / 4;
    for (size_t i = (size_t)blockIdx.x * NTHR + tid; i < n4; i += (size_t)gridDim.x * NTHR) {
        f32x4 h = *((const f32x4*)part + i);
#pragma unroll
        for (int xx = 1; xx < 8; ++xx) h += *((const f32x4*)(part + (size_t)xx * T_TOK * NPAIR) + i);
        const f32x4 g = *((const f32x4*)gates + i);
        *((f32x4*)wout + i) = (f32x4){g[0] * gelu_erf(h[0]), g[1] * gelu_erf(h[1]), g[2] * gelu_erf(h[2]), g[3] * gelu_erf(h[3])};
    }
}
__device__ __forceinline__ void phase9(ArgsP a, LAS unsigned char* lds, int lane, int wave) {
    unsigned char* ws = a->ws; const unsigned char* PV = ws + WS_PV; bf16_t* f = (bf16_t*)(ws + WS_R4);
    const int* idx = (const int*)a->out; const float* wgt = (const float*)(ws + WS_W);
    const int sub = lane & 7, grp = lane >> 3, tp = (lane & 7) * 16 + (lane >> 3);
    LAS u32x2* eb = (LAS u32x2*)(lds + wave * 2048);
#define P9_LD(t_, W0, W1, I0, I1) do { W0 = wgt[(size_t)(t_) * NPAIR + lane]; W1 = wgt[(size_t)(t_) * NPAIR + 64 + lane]; I0 = idx[(size_t)(t_) * NPAIR + lane]; I1 = idx[(size_t)(t_) * NPAIR + 64 + lane]; } while (0)
#define P9_EW(E, W, buf) do { _Pragma("unroll") for (int q_ = 0; q_ < 8; ++q_) { const u32x4 v_ = *(const LAS u32x4*)((buf) + grp * 16 + 2 * q_); E[2 * q_] = (int)v_.x; W[2 * q_] = __uint_as_float(v_.y); E[2 * q_ + 1] = (int)v_.z; W[2 * q_ + 1] = __uint_as_float(v_.w); } } while (0)
#define P9_GATHER(U, E) do { _Pragma("unroll") for (int j_ = 0; j_ < 16; ++j_) U[j_] = *(const u32x4*)(PVx + (size_t)E[j_] * 128); } while (0)
#define P9_TOKEN(U, W, t_) do { f32x2 acc[8] = {{0.f, 0.f}, {0.f, 0.f}, {0.f, 0.f}, {0.f, 0.f}, {0.f, 0.f}, {0.f, 0.f}, {0.f, 0.f}, {0.f, 0.f}}; \
        _Pragma("unroll") for (int j_ = 0; j_ < 16; ++j_) { const f32x2 w2_ = {W[j_], W[j_]}; \
            acc[0] += w2_ * __builtin_amdgcn_cvt_pk_f32_fp8((int)U[j_].x, false); acc[1] += w2_ * __builtin_amdgcn_cvt_pk_f32_fp8((int)U[j_].x, true); acc[2] += w2_ * __builtin_amdgcn_cvt_pk_f32_fp8((int)U[j_].y, false); acc[3] += w2_ * __builtin_amdgcn_cvt_pk_f32_fp8((int)U[j_].y, true); \
            acc[4] += w2_ * __builtin_amdgcn_cvt_pk_f32_fp8((int)U[j_].z, false); acc[5] += w2_ * __builtin_amdgcn_cvt_pk_f32_fp8((int)U[j_].z, true); acc[6] += w2_ * __builtin_amdgcn_cvt_pk_f32_fp8((int)U[j_].w, false); acc[7] += w2_ * __builtin_amdgcn_cvt_pk_f32_fp8((int)U[j_].w, true); } \
        float v_[16]; _Pragma("unroll") for (int k_ = 0; k_ < 8; ++k_) { v_[2 * k_] = acc[k_].x; v_[2 * k_ + 1] = acc[k_].y; } \
        tred8x16<8, 16, 32>(v_, lane);            \
        const int r_ = ((lane >> 3) & 1) * 4 + ((lane >> 4) & 1) * 2 + (lane >> 5); \
        *(unsigned*)(f + (size_t)(t_) * 1024 + x * 128 + sub * 16 + 2 * r_) = pkbf(v_[0] * (1.0f / PEER_V_SCALE), v_[1] * (1.0f / PEER_V_SCALE)); } while (0)
    for (int cell = blockIdx.x; cell < 256; cell += gridDim.x) {
        const int x = cell & 7, c = cell >> 3; const unsigned char* PVx = PV + (size_t)x * (16384 * 128) + sub * 16; const int tend = c * 1024 + 1024;
        int t = c * 1024 + wave;
        float w0, w1; int i0, i1;
        P9_LD(t, w0, w1, i0, i1);
        eb[tp] = (u32x2){(unsigned)i0, __float_as_uint(w0)}; eb[tp + 8] = (u32x2){(unsigned)i1, __float_as_uint(w1)};
        P9_LD(t + 8, w0, w1, i0, i1);
        u32x4 uA[16], uB[16]; int e[16]; float wA[16], wB[16];
        P9_EW(e, wA, eb); P9_GATHER(uA, e);
        for (int n = 0; n < 128; n += 2, t += 16) {
            LAS u32x2* b1 = eb + 128;
            b1[tp] = (u32x2){(unsigned)i0, __float_as_uint(w0)}; b1[tp + 8] = (u32x2){(unsigned)i1, __float_as_uint(w1)};
            { const int tn = t + 16 < tend ? t + 16 : t; P9_LD(tn, w0, w1, i0, i1); }
            P9_EW(e, wB, b1); P9_GATHER(uB, e);
            P9_TOKEN(uA, wA, t);
            eb[tp] = (u32x2){(unsigned)i0, __float_as_uint(w0)}; eb[tp + 8] = (u32x2){(unsigned)i1, __float_as_uint(w1)};
            { const int tn = t + 24 < tend ? t + 24 : t; P9_LD(tn, w0, w1, i0, i1); }
            if (n + 2 < 128) { P9_EW(e, wA, eb); P9_GATHER(uA, e); }
            P9_TOKEN(uB, wB, t + 8);
        }
    }
#undef P9_LD
#undef P9_EW
#undef P9_GATHER
#undef P9_TOKEN
}

constexpr int N_PHASES = 13;
__global__ void __launch_bounds__(NTHR, 2) mk_fwd(Args a_by_value) {
    extern __shared__ __attribute__((aligned(16))) unsigned char lds_raw[];
    LAS unsigned char* lds = (LAS unsigned char*)lds_raw;
    const int tid = threadIdx.x, lane = tid & 63, wave = __builtin_amdgcn_readfirstlane(tid >> 6);
    int lo, hi; { ArgsP a0 = args_ptr(); lo = a0->ph_lo; hi = a0->ph_hi; }
    const int G = gridDim.x;
#ifndef PHMASK
#define PHMASK 0xFFFF
#endif
#define IN(k) (((PHMASK >> (k)) & 1) && lo <= (k) && (k) < hi)
#if defined(MK_CGSYNC)
#define SEAM(k) do { if (IN(k) && IN((k) + 1)) { cg::this_grid().sync(); } } while (0)
#else
    if (tid == 0) { ((LAS unsigned*)(lds + LDS_BAR_OFF))[0] = 0u; ((LAS unsigned*)(lds + LDS_BAR_OFF))[1] = 0u; }
    __syncthreads();
    XcdBarrier xbar; { ArgsP a0 = args_ptr(); xbar = xcd_barrier_post((unsigned*)(a0->ws + WS_BAR) + a0->li * XCD_BAR_WORDS, (volatile LAS unsigned*)(lds + LDS_BAR_OFF)); }
    if (lo < 0) cg::this_grid().sync();
#define SEAM(k) do { if (IN(k) && IN((k) + 1)) { xcd_barrier(xbar); } } while (0)
#endif
    if (IN(0)) { ArgsP a = args_ptr(); phase0(a, lds, tid, lane, wave); }
    SEAM(0);
    if (IN(1)) {
        ArgsP a = args_ptr(); unsigned char* ws = a->ws;
        int k1 = DM; asm volatile("" : "+s"(k1));
        pg8::Gemm g{(const bf16_t*)(ws + WS_R0), (const bf16_t*)(ws + WS_WIN_T), T_TOK, NZ, k1, nullptr, nullptr}; pg8::StaticOrder S; S.init(T_TOK, NZ, G, (int)blockIdx.x);
        static_assert(WS_R2 - WS_R1 == (size_t)T_TOK * 2048 && WS_R3 - WS_R2 == WS_R2 - WS_R1 && WS_R4 - WS_R3 == WS_R2 - WS_R1 && WS_R5 - WS_R4 == WS_R2 - WS_R1, "R1..R5 are consecutive [T][1024] bf16 tensors");
        EpiZ E{(bf16_t*)(ws + WS_R1), (bf16_t*)a->out, a->in[3], 1.0f / WIN_SCALE};
#if defined(MK_CLS)
        const int cls = MK_CLS;
#else
        const int cls = (int)((blockIdx.x >> 3) & 7);
#endif
        phase0_deferred(a, lds, tid, lane, wave, 0, cls);
        pg8::gemm_phase<EpiZ, pg8::StaticOrder, PG8_AL1, PG8_S2, true>(lds, g, S, E);
        phase0_deferred(a, lds, tid, lane, wave, 1, cls);
    }
#if defined(MK_DUPX) && MK_DUPX == 11
    if (IN(1)) {
        ArgsP a = args_ptr(); unsigned char* ws = a->ws; __syncthreads();
        int k1 = DM; asm volatile("" : "+s"(k1));
        pg8::Gemm g{(const bf16_t*)(ws + WS_R0), (const bf16_t*)(ws + WS_WIN_T), T_TOK, NZ, k1, nullptr, nullptr}; pg8::StaticOrder S; S.init(T_TOK, NZ, G, (int)blockIdx.x);
        EpiZ E{(bf16_t*)(ws + WS_R1), (bf16_t*)a->out, a->in[3], 1.0f / WIN_SCALE};
        pg8::gemm_phase<EpiZ, pg8::StaticOrder, PG8_AL1, PG8_S2, true>(lds, g, S, E);
    }
#endif
#if defined(MK_DUPX) && MK_DUPX == 1
    if (IN(1)) {
        ArgsP a = args_ptr(); unsigned char* ws = a->ws; __syncthreads();
        int kprobe = MK_PROBEK; asm volatile("" : "+s"(kprobe));
        pg8::Gemm g{(const bf16_t*)(ws + WS_R0), (const bf16_t*)(ws + WS_WIN_T), T_TOK, NZ, kprobe, nullptr, nullptr}; pg8::StaticOrder S; S.init(T_TOK, NZ, G, (int)blockIdx.x);
        EpiNull E{(float*)(ws + WS_END)};
        pg8::gemm_phase<EpiNull, pg8::StaticOrder, PG8_AL1, PG8_S2, true>(lds, g, S, E);
    }
#endif
    SEAM(1);
    const bool p2_first = ((blockIdx.x >> 3) & 1) == 0;
    if (IN(2) && (p2_first || !IN(3))) { ArgsP a = args_ptr(); phase2(a, lds, tid, lane, wave); }
#if defined(MK_DUPX) && MK_DUPX == 2
    if (IN(2)) { ArgsP a = args_ptr(); phase2(a, lds, tid, lane, wave, true); }
#endif
#if defined(MK_NAIVE_ATTN)
    SEAM(2);
    if (IN(3)) { ArgsP a = args_ptr(); phase3_naive(a, lds, tid, lane, wave); }
#else
    if (IN(3)) { ArgsP a = args_ptr(); phase3_fast(a, lds, tid, lane, wave); }
    if (IN(2) && IN(3) && !p2_first) { __syncthreads(); ArgsP a = args_ptr(); phase2(a, lds, tid, lane, wave); }
#if defined(MK_DUPX) && MK_DUPX == 3
    if (IN(3)) { __syncthreads(); ArgsP a = args_ptr(); phase3_fast<MK_ATTVAR>(a, lds, tid, lane, wave, true); }
#endif
#endif
    SEAM(3);
    if (IN(4)) {
        ArgsP a = args_ptr(); unsigned char* ws = a->ws;
        pg8::Gemm g{(const bf16_t*)(ws + WS_R1), (const bf16_t*)(ws + WS_PA_T), T_TOK, DM, DM, (const bf16_t*)(ws + WS_R3), (const bf16_t*)(ws + WS_PB_T)}; pg8::DualOrder S; S.init(T_TOK, DM, G, (int)blockIdx.x);
        EpiGate E{(bf16_t*)(ws + WS_R2), (const unsigned char*)a->out, (const unsigned char*)a->out + (size_t)T_TOK * 1024};
        pg8::gemm_phase<EpiGate, pg8::DualOrder, PG8_AL, PG8_S2>(lds, g, S, E);
    }
    SEAM(4);
    if (IN(5)) {
        ArgsP a = args_ptr(); unsigned char* ws = a->ws;
        pg8::Gemm g{(const bf16_t*)(ws + WS_R2), (const bf16_t*)(ws + WS_WOUT_T), T_TOK, DM, DM, nullptr, nullptr}; pg8::StaticOrder S; S.init(T_TOK, DM, G, (int)blockIdx.x);
        EpiRes E{a->in[0], (bf16_t*)(ws + WS_R0)};
        pg8::gemm_phase<EpiRes, pg8::StaticOrder, PG8_AL, PG8_S2>(lds, g, S, E);
    }
    SEAM(5);
    if (IN(6)) {
        ArgsP a = args_ptr(); unsigned char* ws = a->ws;
        const bool ln_first = ((blockIdx.x >> 3) & 1) == 0;
        if (ln_first) { phase5b(a, lane, wave); __syncthreads(); }
        int kpl = 256; asm volatile("" : "+s"(kpl));
        pg8::Gemm g{(const bf16_t*)(ws + WS_PB16), (const bf16_t*)(ws + WS_WPLE_T), T_TOK, DM, kpl, nullptr, nullptr}; pg8::StaticOrder S; S.init(T_TOK, DM, G, (int)blockIdx.x);
        EpiMix<0> E{(bf16_t*)(ws + WS_R2), nullptr, nullptr};
        pg8::gemm_phase<EpiMix<0>, pg8::StaticOrder, PG8_AL, PG8_S2>(lds, g, S, E);
        if (!ln_first) { __syncthreads(); phase5b(a, lane, wave); }
    }
    SEAM(6);
    if (IN(7)) {
        ArgsP a = args_ptr(); unsigned char* ws = a->ws;
        pg8::Gemm g{(const bf16_t*)(ws + WS_R3), (const bf16_t*)(ws + WS_WQ2_T), T_TOK, 3072, DM, nullptr, nullptr}; pg8::StaticOrder S; S.init(T_TOK, 3072, G, (int)blockIdx.x);
        EpiP6 E{(float*)(ws + WS_R0), (float*)(ws + WS_R4), (bf16_t*)(ws + WS_R2), a->in[20]};
        pg8::gemm_phase<EpiP6, pg8::StaticOrder, PG8_AL, PG8_S2>(lds, g, S, E);
    }
    SEAM(7);
    if (IN(8)) { ArgsP a = args_ptr(); phase7(a, lds, tid, lane, wave); }
#if defined(MK_DUPX) && MK_DUPX == 8
    if (IN(8)) { __syncthreads(); ArgsP a = args_ptr(); phase7(a, lds, tid, lane, wave); }
#endif
    SEAM(8);
    if (IN(9)) { ArgsP a = args_ptr(); phase8(a, lds, lane, wave); }
    SEAM(9);
    if (IN(10)) { { ArgsP a = args_ptr(); phase9w(a, tid); }
#if defined(MK_CGSYNC)
        cg::this_grid().sync();
#else
        xcd_barrier(xbar);
#endif
        { ArgsP a = args_ptr(); phase9(a, lds, lane, wave); } }
    SEAM(10);
    if (IN(11)) { ArgsP a = args_ptr(); phase10(a, lane, wave); }
#undef IN
#undef SEAM
}


extern "C" void kernel_launch(void* const* d_in, const int* in_sizes, int n_in, void* d_out, int out_size, void* d_ws, size_t ws_size, hipStream_t stream) {
    static int grid = 0;
    if (grid == 0) {
        if (n_in != 23 || in_sizes[0] != T_TOK * DM || out_size != T_TOK * DM || ws_size < 512 * MiB) { fprintf(stderr, "kernel_launch: unexpected shapes (n_in %d, in0 %d, out %d, ws %zu)\n", n_in, n_in > 0 ? in_sizes[0] : -1, out_size, ws_size); grid = -1; return; }
        int dev = 0, cus = 0, per_cu = 0;
        (void)hipGetDevice(&dev); (void)hipDeviceGetAttribute(&cus, hipDeviceAttributeMultiprocessorCount, dev);
        if (hipFuncSetAttribute((const void*)mk_fwd, hipFuncAttributeMaxDynamicSharedMemorySize, LDS_BYTES) != hipSuccess) { fprintf(stderr, "kernel_launch: hipFuncSetAttribute failed\n"); grid = -1; return; }
        if (hipOccupancyMaxActiveBlocksPerMultiprocessor(&per_cu, (const void*)mk_fwd, NTHR, LDS_BYTES) != hipSuccess || per_cu < 1) { fprintf(stderr, "kernel_launch: occupancy query failed (%d)\n", per_cu); grid = -1; return; }
        grid = cus * 1;
    }
    if (grid < 0) return;
    Args a{};
    for (int i = 0; i < 23; ++i) a.in[i] = (const float*)d_in[i];
    a.out = (float*)d_out; a.ws = (unsigned char*)d_ws;
    (void)hipMemsetAsync((unsigned char*)d_ws + WS_BAR, 0, WS_BAR_BYTES, stream);
    int launch_no = 0;
#if defined(MK_DUP)
    {   void* args[] = {&a};
        a.ph_lo = 0; a.ph_hi = MK_DUP + 1; a.li = launch_no++; (void)hipLaunchCooperativeKernel((const void*)mk_fwd, dim3(grid), dim3(NTHR), args, LDS_BYTES, stream);
        a.ph_lo = MK_DUP; a.ph_hi = 12; a.li = launch_no++; (void)hipLaunchCooperativeKernel((const void*)mk_fwd, dim3(grid), dim3(NTHR), args, LDS_BYTES, stream);
    }
#else
    a.ph_lo = 0; a.ph_hi = 12;
    void* args[] = {&a};
    hipError_t e = hipLaunchCooperativeKernel((const void*)mk_fwd, dim3(grid), dim3(NTHR), args, LDS_BYTES, stream);
    if (e != hipSuccess) fprintf(stderr, "kernel_launch: cooperative launch failed: %s (grid %d)\n", hipGetErrorString(e), grid);
#endif
}
```
